# Optimizing an MI355X kernel written in HIP

```python
import math
import jax, jax.numpy as jnp
from jax import lax
import numpy as np

D_MODEL = 1024
BATCH = 4
SEQ = 8192
DEPTH = 1

MLA_HEADS = 8
MLA_NOPE = 64
MLA_ROPE = 32
MLA_V = 64
Q_LORA = 256
KV_LORA = 128
D_MLA = MLA_HEADS * MLA_V
MLA_SCALE = 1.0 / math.sqrt(MLA_NOPE + MLA_ROPE)
ROPE_BASE = 10000.0

SWA_HEADS = 8
SWA_KV_HEADS = 2
SWA_HEAD_DIM = 64
SWA_GROUP = SWA_HEADS // SWA_KV_HEADS
D_SWA = SWA_HEADS * SWA_HEAD_DIM
WINDOW = 128
BLOCK = 128
SWA_SCALE = 1.0 / math.sqrt(SWA_HEAD_DIM)

N_BUCKETS = 32
MAX_DISTANCE = 128

D_MIX = D_MLA + D_SWA

ALPHA = (2.0 * DEPTH) ** 0.25
BETA = (8.0 * DEPTH) ** -0.25

IN_SPLITS = (Q_LORA, KV_LORA, MLA_ROPE, D_MLA,
             SWA_HEADS * SWA_HEAD_DIM, SWA_KV_HEADS * SWA_HEAD_DIM,
             SWA_KV_HEADS * SWA_HEAD_DIM, D_SWA)
D_IN = int(sum(IN_SPLITS))
IN_OFFSETS = tuple(int(o) for o in np.cumsum(IN_SPLITS)[:-1])

kernel_name = "hybrid_mla_swa_deepnorm_block"


def _rms_norm(x, g, eps=1e-6):
    xf = x.astype(jnp.float32)
    y = xf * lax.rsqrt(jnp.mean(xf * xf, axis=-1, keepdims=True) + eps)
    return y.astype(x.dtype) * g


def _layer_norm(x, g, b, eps=1e-5):
    xf = x.astype(jnp.float32)
    mu = jnp.mean(xf, axis=-1, keepdims=True)
    var = jnp.mean(jnp.square(xf - mu), axis=-1, keepdims=True)
    return ((xf - mu) * lax.rsqrt(var + eps)).astype(x.dtype) * g + b


def _rope(x, cos, sin):
    half = x.shape[-1] // 2
    x1, x2 = x[..., :half], x[..., half:]
    cos = cos.astype(x.dtype)
    sin = sin.astype(x.dtype)
    return jnp.concatenate([x1 * cos - x2 * sin, x2 * cos + x1 * sin], axis=-1)


def _t5_bucket(rel):
    half = N_BUCKETS // 2
    ret = np.where(rel > 0, half, 0)
    n = np.abs(rel)
    max_exact = half // 2
    large = max_exact + (np.log(np.maximum(n, 1).astype(np.float32) / max_exact)
                         / np.log(MAX_DISTANCE / max_exact) * (half - max_exact)).astype(np.int32)
    large = np.minimum(large, half - 1)
    return (ret + np.where(n < max_exact, n, large)).astype(np.int32)


def _mla(c_q, c_kv, k_rope, g_q, g_kv, w_uq, w_ukv, cos, sin):
    B, S, _ = c_q.shape
    nb = S // BLOCK
    q = (_rms_norm(c_q, g_q) @ w_uq).reshape(B, S, MLA_HEADS, MLA_NOPE + MLA_ROPE)
    q_nope = q[..., :MLA_NOPE]
    q_rope = _rope(q[..., MLA_NOPE:], cos[:, None, :], sin[:, None, :])
    kv = (_rms_norm(c_kv, g_kv) @ w_ukv).reshape(B, S, MLA_HEADS, MLA_NOPE + MLA_V)
    k_nope, v = kv[..., :MLA_NOPE], kv[..., MLA_NOPE:]
    k_r = _rope(k_rope, cos, sin)
    qn = q_nope.reshape(B, nb, BLOCK, MLA_HEADS, MLA_NOPE).transpose(1, 0, 2, 3, 4)
    qr = q_rope.reshape(B, nb, BLOCK, MLA_HEADS, MLA_ROPE).transpose(1, 0, 2, 3, 4)

    def attend_block(args):
        qn_b, qr_b = args
        s = (jnp.einsum('bqhd,bkhd->bhqk', qn_b, k_nope)
             + jnp.einsum('bqhr,bkr->bhqk', qr_b, k_r)).astype(jnp.float32) * MLA_SCALE
        p = jax.nn.softmax(s, axis=-1).astype(v.dtype)
        return jnp.einsum('bhqk,bkhd->bqhd', p, v)

    o = lax.map(attend_block, (qn, qr))
    return o.transpose(1, 0, 2, 3, 4).reshape(B, S, D_MLA)


def _swa(q, k, v, sink, rel_bias):
    B, S, _, _ = q.shape
    nb = S // BLOCK
    qb = q.reshape(B, nb, BLOCK, SWA_KV_HEADS, SWA_GROUP, SWA_HEAD_DIM)
    pad = ((0, 0), (BLOCK, BLOCK), (0, 0), (0, 0))
    kp = jnp.pad(k, pad).reshape(B, nb + 2, BLOCK, SWA_KV_HEADS, SWA_HEAD_DIM)
    vp = jnp.pad(v, pad).reshape(B, nb + 2, BLOCK, SWA_KV_HEADS, SWA_HEAD_DIM)
    kband = jnp.concatenate([kp[:, :-2], kp[:, 1:-1], kp[:, 2:]], axis=2)
    vband = jnp.concatenate([vp[:, :-2], vp[:, 1:-1], vp[:, 2:]], axis=2)

    q_loc = np.arange(BLOCK)
    k_loc = np.arange(3 * BLOCK) - BLOCK
    rel = k_loc[None, :] - q_loc[:, None]
    band = np.abs(rel) <= WINDOW
    bucket = _t5_bucket(rel)
    bias = rel_bias[bucket].astype(jnp.float32)
    bias = bias.transpose(2, 0, 1).reshape(SWA_KV_HEADS, SWA_GROUP, BLOCK, 3 * BLOCK)

    k_abs = jnp.arange(nb)[:, None] * BLOCK + jnp.asarray(k_loc)[None, :]
    valid = (k_abs >= 0) & (k_abs < S)
    mask = jnp.asarray(band)[None, :, :] & valid[:, None, :]

    s = jnp.einsum('bnqhgd,bnjhd->bnhgqj', qb, kband).astype(jnp.float32) * SWA_SCALE
    s = jnp.where(mask[None, :, None, None], s + bias, -jnp.inf)
    sink_b = sink.astype(jnp.float32).reshape(SWA_KV_HEADS, SWA_GROUP)[None, None, :, :, None, None]
    m = jnp.maximum(jnp.max(s, axis=-1, keepdims=True), sink_b)
    e = jnp.exp(s - m)
    p = e / (jnp.sum(e, axis=-1, keepdims=True) + jnp.exp(sink_b - m))
    o = jnp.einsum('bnhgqj,bnjhd->bnqhgd', p.astype(v.dtype), vband)
    return o.reshape(B, S, D_SWA)


def setup_inputs(seed: int = 0) -> dict:
    key = jax.random.key(seed)
    ks = jax.random.split(key, 12)
    f32 = jnp.float32
    x = jax.random.normal(ks[0], (BATCH, SEQ, D_MODEL), f32)
    w_in = jax.random.normal(ks[1], (D_MODEL, D_IN), f32) * D_MODEL ** -0.5
    g_q = 1.0 + 0.05 * jax.random.normal(ks[2], (Q_LORA,), f32)
    g_kv = 1.0 + 0.05 * jax.random.normal(ks[3], (KV_LORA,), f32)
    w_uq = jax.random.normal(ks[4], (Q_LORA, MLA_HEADS * (MLA_NOPE + MLA_ROPE)), f32) * Q_LORA ** -0.5
    w_ukv = jax.random.normal(ks[5], (KV_LORA, MLA_HEADS * (MLA_NOPE + MLA_V)), f32) * KV_LORA ** -0.5
    sink = 0.5 * jax.random.normal(ks[6], (SWA_HEADS,), f32)
    rel_bias = 0.5 * jax.random.normal(ks[7], (N_BUCKETS, SWA_HEADS), f32)
    w_out = jax.random.normal(ks[8], (D_MIX, D_MODEL), f32) * (D_MIX ** -0.5) * BETA
    ln_g = 1.0 + 0.05 * jax.random.normal(ks[9], (D_MODEL,), f32)
    ln_b = 0.02 * jax.random.normal(ks[10], (D_MODEL,), f32)
    return {"x": x, "w_in": w_in, "g_q": g_q, "g_kv": g_kv, "w_uq": w_uq,
            "w_ukv": w_ukv, "sink": sink, "rel_bias": rel_bias, "w_out": w_out,
            "ln_g": ln_g, "ln_b": ln_b}


def reference(x, w_in, g_q, g_kv, w_uq, w_ukv, sink, rel_bias, w_out, ln_g, ln_b):
    B, S, _ = x.shape
    pos = jnp.arange(S, dtype=jnp.float32)
    inv_freq = ROPE_BASE ** (-jnp.arange(0, MLA_ROPE, 2, dtype=jnp.float32) / MLA_ROPE)
    ang = pos[:, None] * inv_freq[None, :]
    cos, sin = jnp.cos(ang), jnp.sin(ang)

    h = x
    for _layer in range(DEPTH):
        proj = h @ w_in
        c_q, c_kv, k_rope, gate_a, q_s, k_s, v_s, gate_b = jnp.split(proj, IN_OFFSETS, axis=-1)
        o_a = _mla(c_q, c_kv, k_rope, g_q, g_kv, w_uq, w_ukv, cos, sin)
        o_b = _swa(q_s.reshape(B, S, SWA_HEADS, SWA_HEAD_DIM),
                   k_s.reshape(B, S, SWA_KV_HEADS, SWA_HEAD_DIM),
                   v_s.reshape(B, S, SWA_KV_HEADS, SWA_HEAD_DIM),
                   sink, rel_bias)
        mixed = jnp.concatenate([o_a * jax.nn.silu(gate_a), o_b * jax.nn.silu(gate_b)], axis=-1)
        h = _layer_norm(ALPHA * h + mixed @ w_out, ln_g, ln_b)
    return h
```

```cpp
#include <hip/hip_runtime.h>
#include <cstdio>
#include <cstdint>
#include <cmath>

constexpr int NBATCH = 4, SEQ = 8192, DMODEL = 1024, MTOK = NBATCH * SEQ;
constexpr int D_IN = 2208;
constexpr int NPROJ = 2304;
constexpr int PC_CQ = 0;           constexpr int SC_CQ = 0;
constexpr int PC_CKV = 256;        constexpr int SC_CKV = 256;
constexpr int PC_KR = 384;         constexpr int SC_KR = 384;
constexpr int PC_GA = 512;         constexpr int SC_GA = 416;
constexpr int PC_QS = 1024;        constexpr int SC_QS = 928;
constexpr int PC_KS = 1536;        constexpr int SC_KS = 1440;
constexpr int PC_VS = 1664;        constexpr int SC_VS = 1568;
constexpr int PC_GB = 1792;        constexpr int SC_GB = 1696;
constexpr int QM_PITCH = 768, KM_PITCH = 768, VM_PITCH = 512, MIX_PITCH = 1024;
constexpr int NUP = 1792;
constexpr float LOG2E = 1.4426950408889634f;
constexpr float MLA_QSCALE = 0.10206207261596575f * LOG2E;
constexpr float SWA_QSCALE = 0.125f * LOG2E;
constexpr float ALPHA_RES = 1.189207115002721f;
constexpr float RMS_EPS = 1e-6f, LN_EPS = 1e-5f;
constexpr int TB_N = 768;
constexpr float NEG_BIG = -1.0e30f;

#define GAS __attribute__((address_space(1)))
#define LAS __attribute__((address_space(3)))
typedef unsigned short bf16_t;
typedef short bf16x8 __attribute__((ext_vector_type(8)));
typedef short s16x4 __attribute__((ext_vector_type(4)));
typedef float f32x4 __attribute__((ext_vector_type(4)));
typedef float f32x2 __attribute__((ext_vector_type(2)));
typedef float f32x16 __attribute__((ext_vector_type(16)));
typedef unsigned u32x4 __attribute__((ext_vector_type(4)));
typedef unsigned u32x2 __attribute__((ext_vector_type(2)));
typedef __bf16 bf16x2_t __attribute__((ext_vector_type(2)));

__device__ __forceinline__ unsigned cvt_pk_bf16(float lo, float hi) { f32x2 v = {lo, hi}; bf16x2_t b = __builtin_convertvector(v, bf16x2_t); return __builtin_bit_cast(unsigned, b); }
__device__ __forceinline__ float bf_lo(unsigned w) { return __uint_as_float(w << 16); }
__device__ __forceinline__ float bf_hi(unsigned w) { return __uint_as_float(w & 0xffff0000u); }
__device__ __forceinline__ int fresh_tid() { int t = threadIdx.x; asm volatile("" : "+v"(t)); return t; }
__device__ __forceinline__ float silu_f(float x) { return x * __builtin_amdgcn_rcpf(1.0f + __builtin_amdgcn_exp2f(-x * LOG2E)); }

namespace pg8 {
constexpr int BM = 256, BK = 64, HALF = 128, HTB = HALF * BK * 2  , STAGE_BYTES = 8 * HTB, NXCD = 8, WGM = 8;
__host__ __device__ __forceinline__ int lds_byte(int r, int c) { const int st = (r >> 4) * 2 + (c >> 5), rr = r & 15, cc = c & 31, ob = rr * 64 + cc * 2; return st * 1024 + (ob ^ (((ob >> 9) & 1) << 5)); }
__host__ __device__ __forceinline__ void stage_rc(int b, int& R, int& C) { const int st = b / 1024, sb = b % 1024, swz = sb ^ (((sb >> 9) & 1) << 5); R = (st >> 1) * 16 + swz / 64; C = (st & 1) * 32 + (swz % 64) / 2; }
__host__ __device__ __forceinline__ int perm32(int rho) { const int n = rho >> 4, i = rho & 15; return 8 * (i >> 2) + 4 * n + (i & 3); }

struct Unit { int pm, pn; };
struct Gemm { const bf16_t* A; const bf16_t* Bt; };
template <int LDA_, int LDB_, int K_, int PN_SPLIT_, int A_OFF2_> struct GemmCfg { static constexpr int LDA = LDA_, LDB = LDB_, K = K_, PN_SPLIT = PN_SPLIT_, A_OFF2 = A_OFF2_; };

struct StaticOrder {
    int nM, nN, nwg, G, c;
    __device__ void init(int nM_, int nN_, int G_, int c_) { nM = nM_; nN = nN_; nwg = nM * nN; G = G_; c = c_; }
    __device__ bool next(int i, Unit& u) const {
        const long L = (long)i * G + c; if (L >= nwg) return false;
        int wgid = (int)L; { const int q = nwg / NXCD, r = nwg % NXCD, xcd = wgid % NXCD, off = wgid / NXCD; wgid = (xcd < r ? xcd * (q + 1) : r * (q + 1) + (xcd - r) * q) + off; }
        const int nig = WGM * nN, gid = wgid / nig, fm = gid * WGM, gsz = (nM - fm) < WGM ? (nM - fm) : WGM;
        u.pm = fm + ((wgid % nig) % gsz); u.pn = (wgid % nig) / gsz; return true;
    }
};


__device__ __forceinline__ void rope8(f32x4& v0, f32x4& v1, const float* cs, int i0) {
    const f32x4 c = *(const f32x4*)(cs + i0), s = *(const f32x4*)(cs + 16 + i0);
    const float a0 = v0[0], b0 = v0[1], a1 = v0[2], b1 = v0[3], a2 = v1[0], b2 = v1[1], a3 = v1[2], b3 = v1[3];
    v0[0] = a0 * c[0] - b0 * s[0]; v0[1] = b0 * c[0] + a0 * s[0];
    v0[2] = a1 * c[1] - b1 * s[1]; v0[3] = b1 * c[1] + a1 * s[1];
    v1[0] = a2 * c[2] - b2 * s[2]; v1[1] = b2 * c[2] + a2 * s[2];
    v1[2] = a3 * c[3] - b3 * s[3]; v1[3] = b3 * c[3] + a3 * s[3];
}
__device__ __forceinline__ u32x4 pack8(const f32x4& v0, const f32x4& v1) { u32x4 w; w.x = cvt_pk_bf16(v0[0], v0[1]); w.y = cvt_pk_bf16(v0[2], v0[3]); w.z = cvt_pk_bf16(v1[0], v1[1]); w.w = cvt_pk_bf16(v1[2], v1[3]); return w; }

struct EpiProj {
    static constexpr bool PERM = true;
    bf16_t* PROJ; bf16_t* Km; float* SSQ; const float* CS;
    __device__ __forceinline__ void operator()(const f32x4 (&acc)[2][2][4][2], const Unit& u, int wr, int wc, int fr, int fq) const {
        asm volatile("" : "+v"(fr), "+v"(fq));
        const int pn = u.pn;
        const int row0 = u.pm * BM + wr * 64 + fr;
        const int col0 = pn * BM + wc * 32 + 8 * fq;
        int mode[2];
#pragma unroll
        for (int bj = 0; bj < 2; ++bj) {
            int md = 0;
            if (pn == 0) md = 1;
            else if (pn == 1) md = (bj == 0) ? 1 : ((wc == 0) ? 4 : 0);
            else if (pn == 2 || pn == 3 || pn >= 7) md = 2;
            else if (pn == 4 || pn == 5) md = 3;
            mode[bj] = md;
        }
#pragma unroll
        for (int ai = 0; ai < 2; ++ai)
#pragma unroll
            for (int m = 0; m < 4; ++m) {
                const int row = row0 + ai * HALF + m * 16;
                bf16_t* rowp = PROJ + (size_t)row * NPROJ + col0;
                float ss = 0.f;
#pragma unroll
                for (int bj = 0; bj < 2; ++bj) {
                    f32x4 v0 = acc[ai][bj][m][0], v1 = acc[ai][bj][m][1];
                    const int md = mode[bj];
                    if (md == 1) { ss += (v0[0] * v0[0] + v0[1] * v0[1]) + (v0[2] * v0[2] + v0[3] * v0[3]) + (v1[0] * v1[0] + v1[1] * v1[1]) + (v1[2] * v1[2] + v1[3] * v1[3]); }
                    else if (md == 2) {
#pragma unroll
                        for (int e = 0; e < 4; ++e) { v0[e] = silu_f(v0[e]); v1[e] = silu_f(v1[e]); }
                    } else if (md == 3) { v0 = v0 * SWA_QSCALE; v1 = v1 * SWA_QSCALE; }
                    else if (md == 4) { rope8(v0, v1, CS + (size_t)(row & (SEQ - 1)) * 32, 4 * fq); }
                    const u32x4 w = pack8(v0, v1);
                    *(u32x4*)(rowp + bj * HALF) = w;
                    if (md == 4) {
                        bf16_t* kp = Km + (size_t)row * KM_PITCH + 64 + 8 * fq;
#pragma unroll
                        for (int h = 0; h < 8; ++h) *(u32x4*)(kp + h * 96) = w;
                    }
                }
                if (pn <= 1) {
                    ss += __shfl_xor(ss, 16); ss += __shfl_xor(ss, 32);
                    if (fq == 0) SSQ[(size_t)row * 8 + pn * 4 + wc] = ss;
                }
                asm volatile("" ::: "memory");
            }
    }
};

struct EpiUp {
    static constexpr bool PERM = true;
    bf16_t* Qm; bf16_t* Km; bf16_t* Vm; const float* SSQ; const float* CS;
    __device__ __forceinline__ void operator()(const f32x4 (&acc)[2][2][4][2], const Unit& u, int wr, int wc, int fr, int fq) const {
        asm volatile("" : "+v"(fr), "+v"(fq));
        const int pn = u.pn;
        const int row0 = u.pm * BM + wr * 64 + fr;
        const bool isq = pn < 3;
#pragma unroll
        for (int ai = 0; ai < 2; ++ai)
#pragma unroll
            for (int m = 0; m < 4; ++m) {
                const int row = row0 + ai * HALF + m * 16;
                const f32x4 s4 = *(const f32x4*)(SSQ + (size_t)row * 8 + (isq ? 0 : 4));
                const float ssum = (s4[0] + s4[1]) + (s4[2] + s4[3]);
                const float rstd = 1.0f / sqrtf(ssum * (isq ? (1.0f / 256.0f) : (1.0f / 128.0f)) + RMS_EPS);
                const float sc = isq ? rstd * MLA_QSCALE : rstd;
#pragma unroll
                for (int bj = 0; bj < 2; ++bj) {
                    f32x4 v0 = acc[ai][bj][m][0] * sc, v1 = acc[ai][bj][m][1] * sc;
                    bf16_t* dst;
                    if (isq) {
                        const int blk = 8 * pn + 4 * bj + wc;
                        if (blk % 3 == 2) rope8(v0, v1, CS + (size_t)(row & (SEQ - 1)) * 32, 4 * fq);
                        dst = Qm + (size_t)row * QM_PITCH + pn * BM + bj * HALF + wc * 32 + 8 * fq;
                    } else if (pn < 5) {
                        const int c = (pn - 3) * BM + bj * HALF + wc * 32 + 8 * fq;
                        dst = Km + (size_t)row * KM_PITCH + (c >> 6) * 96 + (c & 63);
                    } else {
                        const int c = (pn - 5) * BM + bj * HALF + wc * 32 + 8 * fq;
                        dst = Vm + (size_t)row * VM_PITCH + c;
                    }
                    *(u32x4*)dst = pack8(v0, v1);
                }
                asm volatile("" ::: "memory");
            }
    }
};

struct EpiOut {
    static constexpr bool PERM = false;
    const float* X; float* OUT;
    __device__ __forceinline__ void operator()(const f32x4 (&acc)[2][2][4][2], const Unit& u, int wr, int wc, int fr, int fq) const {
        asm volatile("" : "+v"(fr), "+v"(fq));
        const int row0 = u.pm * BM + wr * 64 + fr;
        const int col0 = u.pn * BM + wc * 32 + 4 * fq;
#pragma unroll
        for (int ai = 0; ai < 2; ++ai)
#pragma unroll
            for (int m = 0; m < 4; ++m) {
                const size_t off = (size_t)(row0 + ai * HALF + m * 16) * DMODEL + col0;
#pragma unroll
                for (int bj = 0; bj < 2; ++bj)
#pragma unroll
                    for (int n = 0; n < 2; ++n) {
                        const f32x4 xv = *(const f32x4*)(X + off + bj * HALF + n * 16);
                        *(f32x4*)(OUT + off + bj * HALF + n * 16) = xv * ALPHA_RES + acc[ai][bj][m][n];
                    }
            }
    }
};

template <class Cfg, class Epi, bool ALIGN_EPI>
__device__ __forceinline__ void gemm_phase(LAS unsigned char* lds, const Gemm g, const StaticOrder& S, const Epi& E) {
    const int tid = fresh_tid(), wid = __builtin_amdgcn_readfirstlane(tid >> 6), lane = tid & 63, wr = wid >> 2, wc = wid & 3, fr = lane & 15, fq = lane >> 4;
    constexpr int nt = Cfg::K / BK;
    unsigned voffA[2], voffB[2];
#pragma unroll
    for (int i = 0; i < 2; ++i) { int R, C; stage_rc(tid * 16 + i * 8192, R, C); const int Rb = Epi::PERM ? ((R & ~31) + perm32(R & 31)) : R;
        voffA[i] = (unsigned)(R * Cfg::LDA + C) * 2u; voffB[i] = (unsigned)(Rb * Cfg::LDB + C) * 2u; }
    const size_t kstep = (size_t)(BK * 2);
    constexpr size_t hA = (size_t)HALF * Cfg::LDA * 2, hB = (size_t)HALF * Cfg::LDB * 2;
    constexpr size_t tA = 2 * hA, tB = 2 * hB;
    const unsigned ldsw = (unsigned)wid * 1024u;
    const int aoff = lds_byte(wr * 64 + fr, fq * 8), boff = lds_byte(wc * 32 + fr, fq * 8);
#define PG8_SA(b, h) (((b) * 2 + (h)) * HTB)
#define PG8_SB(b, h) ((4 + (b) * 2 + (h)) * HTB)
#define PG8_STAGE(bufoff, gbase, voff) do { _Pragma("unroll") for (int _i = 0; _i < 2; ++_i) \
        __builtin_amdgcn_global_load_lds((const unsigned*)((const char*)(gbase) + (voff)[_i]), (LAS unsigned*)(lds + (bufoff) + ldsw + _i * 8192), 16, 0, 0); } while (0)
#define PG8_LDA(dst, b, h) do { _Pragma("unroll") for (int m = 0; m < 4; ++m) _Pragma("unroll") for (int k = 0; k < 2; ++k) dst[m][k] = *(const LAS bf16x8*)(lds + PG8_SA(b, h) + aoff + m * 2048 + k * 1024); } while (0)
#define PG8_LDB(dst, b, h) do { _Pragma("unroll") for (int n = 0; n < 2; ++n) _Pragma("unroll") for (int k = 0; k < 2; ++k) dst[n][k] = *(const LAS bf16x8*)(lds + PG8_SB(b, h) + boff + n * 2048 + k * 1024); } while (0)
#define PG8_MMA(ai, bj, At, Bt) do { __builtin_amdgcn_s_setprio(1); _Pragma("unroll") for (int m = 0; m < 4; ++m) _Pragma("unroll") for (int n = 0; n < 2; ++n) _Pragma("unroll") for (int k = 0; k < 2; ++k) \
        acc[ai][bj][m][n] = __builtin_amdgcn_mfma_f32_16x16x32_bf16(Bt[n][k], At[m][k], acc[ai][bj][m][n], 0, 0, 0); __builtin_amdgcn_s_setprio(0); } while (0)
#define PG8_WAIT_V(n) asm volatile("s_waitcnt vmcnt(" #n ")" ::: "memory")
#define PG8_WAIT_L(n) asm volatile("s_waitcnt lgkmcnt(" #n ")" ::: "memory")
#define PG8_BAR __builtin_amdgcn_s_barrier()
#define PG8_SCHED __builtin_amdgcn_sched_barrier(0)
#define PG8_ABASE(u) ((const char*)g.A + (size_t)(u).pm * tA + ((u).pn >= Cfg::PN_SPLIT ? (size_t)Cfg::A_OFF2 * 2 : (size_t)0))
#define PG8_BBASE(u) ((const char*)g.Bt + (size_t)(u).pn * tB)
    Unit cur, nxt; int ui = 0;
    if (!S.next(0, cur)) return;
    f32x4 acc[2][2][4][2];
#pragma unroll
    for (int a = 0; a < 2; ++a)
#pragma unroll
        for (int b = 0; b < 2; ++b)
#pragma unroll
            for (int m = 0; m < 4; ++m)
#pragma unroll
                for (int n = 0; n < 2; ++n) acc[a][b][m][n] = (f32x4){0.f, 0.f, 0.f, 0.f};
    bf16x8 At[4][2], B0[2][2], B1[2][2];
    const char* cA = PG8_ABASE(cur); const char* cB = PG8_BBASE(cur);
    PG8_STAGE(PG8_SB(0, 0), cB, voffB); PG8_STAGE(PG8_SB(0, 1), cB + hB, voffB); PG8_STAGE(PG8_SA(0, 0), cA, voffA); PG8_STAGE(PG8_SA(0, 1), cA + hA, voffA);
    if (wr == 1) PG8_BAR;
    PG8_WAIT_V(2); PG8_BAR;
    PG8_STAGE(PG8_SB(1, 0), cB + kstep, voffB); PG8_STAGE(PG8_SA(1, 0), cA + kstep, voffA); PG8_STAGE(PG8_SB(1, 1), cB + hB + kstep, voffB);
    PG8_WAIT_V(6); PG8_BAR;
    for (;;) {
        const bool has_next = S.next(ui + 1, nxt);
        const char* nA = has_next ? PG8_ABASE(nxt) : cA; const char* nB = has_next ? PG8_BBASE(nxt) : cB;
        for (int t = 0; t < nt; t += 2) {
            const bool last = (t == nt - 2);
            const char* a1 = cA + (size_t)(t + 1) * kstep;
            const char* a2 = last ? nA : cA + (size_t)(t + 2) * kstep; const char* b2 = last ? nB : cB + (size_t)(t + 2) * kstep;
            const char* a3 = a2 + kstep; const char* b3 = b2 + kstep;
            PG8_LDB(B0, 0, 0); PG8_LDB(B1, 0, 1); PG8_SCHED; PG8_LDA(At, 0, 0); PG8_STAGE(PG8_SA(1, 1), a1 + hA, voffA);
            PG8_WAIT_V(8); PG8_WAIT_L(0); PG8_BAR; PG8_MMA(0, 0, At, B0); PG8_MMA(0, 1, At, B1); PG8_BAR; PG8_SCHED;
            PG8_LDA(At, 0, 1); PG8_STAGE(PG8_SB(0, 0), b2, voffB); PG8_STAGE(PG8_SB(0, 1), b2 + hB, voffB); PG8_STAGE(PG8_SA(0, 0), a2, voffA);
            PG8_WAIT_V(8); PG8_WAIT_L(0); PG8_BAR; PG8_MMA(1, 0, At, B0); PG8_MMA(1, 1, At, B1); PG8_BAR; PG8_SCHED;
            PG8_LDB(B0, 1, 0); PG8_LDB(B1, 1, 1); PG8_SCHED; PG8_LDA(At, 1, 0); PG8_STAGE(PG8_SA(0, 1), a2 + hA, voffA);
            PG8_WAIT_V(8); PG8_WAIT_L(0); PG8_BAR; PG8_MMA(0, 0, At, B0); PG8_MMA(0, 1, At, B1); PG8_BAR; PG8_SCHED;
            PG8_LDA(At, 1, 1); PG8_STAGE(PG8_SB(1, 0), b3, voffB); PG8_STAGE(PG8_SB(1, 1), b3 + hB, voffB); PG8_STAGE(PG8_SA(1, 0), a3, voffA);
            PG8_WAIT_V(8); PG8_WAIT_L(0); PG8_BAR; PG8_MMA(1, 0, At, B0); PG8_MMA(1, 1, At, B1); PG8_BAR; PG8_SCHED;
        }
        if constexpr (ALIGN_EPI) { if (wr == 0) PG8_BAR; }
        E(acc, cur, wr, wc, fr, fq);
        if (!has_next) break;
#pragma unroll
        for (int a = 0; a < 2; ++a)
#pragma unroll
            for (int b = 0; b < 2; ++b)
#pragma unroll
                for (int m = 0; m < 4; ++m)
#pragma unroll
                    for (int n = 0; n < 2; ++n) acc[a][b][m][n] = (f32x4){0.f, 0.f, 0.f, 0.f};
        cur = nxt; cA = nA; cB = nB; ++ui;
        if constexpr (ALIGN_EPI) { if (wr == 1) PG8_BAR; }
    }
    PG8_WAIT_V(0);
    if constexpr (!ALIGN_EPI) { if (wr == 0) PG8_BAR; }
    PG8_BAR;
#undef PG8_SA
#undef PG8_SB
#undef PG8_STAGE
#undef PG8_LDA
#undef PG8_LDB
#undef PG8_MMA
#undef PG8_WAIT_V
#undef PG8_WAIT_L
#undef PG8_BAR
#undef PG8_SCHED
#undef PG8_ABASE
#undef PG8_BBASE
}
}

namespace attn {
constexpr int KSLOT = 12288, VSLOT = 8192;
constexpr int LDS_K = 0, LDS_V = 3 * KSLOT, LDS_WS = LDS_V + 3 * VSLOT, LDS_OST = LDS_WS + 8 * 256, LDS_TB = LDS_OST + 8 * 4096, LDS_BYTES = LDS_TB + TB_N * 4;
typedef LAS const char* lds_cptr;
typedef short v4i16_t __attribute__((ext_vector_type(4)));
#define SBAR() __builtin_amdgcn_sched_barrier(0)
#define PIN(x) asm volatile("" : "+v"(x))
#define MFMA32(a, b, c) __builtin_amdgcn_mfma_f32_32x32x16_bf16(a, b, c, 0, 0, 0)
#define WAIT_BAR(N) asm volatile("s_waitcnt vmcnt(" #N ") lgkmcnt(0)\n\ts_barrier" ::: "memory")
__device__ __forceinline__ int crow(int r, int hi) { return (r & 3) + 8 * (r >> 2) + 4 * hi; }
__device__ __forceinline__ void glds16(const void* gsrc, unsigned lds_dst) { unsigned keep;
    asm volatile("s_mov_b32 %0, m0\n\ts_mov_b32 m0, %2\n\ts_nop 0\n\tglobal_load_lds_dwordx4 %1, off\n\ts_mov_b32 m0, %0" : "=&s"(keep) : "v"(gsrc), "s"(lds_dst) : "memory"); }
__device__ __forceinline__ s16x4 vtr(lds_cptr p) { return __builtin_bit_cast(s16x4, __builtin_amdgcn_ds_read_tr16_b64_v4i16((LAS v4i16_t*)p)); }
#define MX3(a, b, c) __builtin_fmaxf(__builtin_fmaxf((a), (b)), (c))
__device__ __forceinline__ float rowmax(const f32x16& p0, const f32x16& p1) {
    float a = MX3(p0[0], p0[1], p1[0]), b = MX3(p0[2], p0[3], p1[1]); a = MX3(a, p1[2], p1[3]);
#pragma unroll
    for (int r = 4; r < 16; r += 4) { a = MX3(a, p0[r], p0[r + 1]); b = MX3(b, p0[r + 2], p0[r + 3]); a = MX3(a, p1[r], p1[r + 1]); b = MX3(b, p1[r + 2], p1[r + 3]); }
    float m = __builtin_fmaxf(a, b); auto rr = __builtin_amdgcn_permlane32_swap(__float_as_uint(m), __float_as_uint(m), false, false);
    return __builtin_fmaxf(__uint_as_float(rr[0]), __uint_as_float(rr[1]));
}

struct Tensors {
    const bf16_t* Q; int pitchQ;
    const bf16_t* K; int pitchK;
    const bf16_t* V; int pitchV;
    const bf16_t* G; int pitchG;
    bf16_t* O; int pitchO;
};

template <int DQK, bool SWA, int THR>
__device__ __forceinline__ void attn_unit(const Tensors& T, int b, int qcol, int kcol, int vcol, int ocol, int qb, LAS unsigned char* shm, unsigned lds0,
                                          const float* tb_g  , float sink2  ) {
    constexpr int ND = DQK / 16;
    constexpr int NBK = (DQK == 96) ? 2 : 1;
    const int tid = fresh_tid(), lane = tid & 63, r32 = lane & 31, hi = lane >> 5; const int wid = __builtin_amdgcn_readfirstlane(tid >> 6);
    const bool grpB = wid >= 4;
    const long rowbase = (long)b * SEQ; const int q0 = qb * 256;
    int t_lo = 0, t_hi = SEQ / 64;
    if (SWA) { t_lo = 4 * qb - 2; if (t_lo < 0) t_lo = 0; t_hi = 4 * qb + 6; if (t_hi > SEQ / 64) t_hi = SEQ / 64; }
    const int NT = t_hi - t_lo;
    const bf16_t* Qw = T.Q + (rowbase + q0 + wid * 32) * T.pitchQ + qcol;
    const bf16_t* Kh = T.K + (rowbase + (long)t_lo * 64) * T.pitchK + kcol;
    const bf16_t* Vh = T.V + (rowbase + (long)t_lo * 64) * T.pitchV + vcol;
    LAS float* wsf = (LAS float*)(shm + LDS_WS) + wid * 64;
    const bf16_t* ksrc = Kh + (long)lane * T.pitchK + wid * 8;
    const bf16_t* krsrc = Kh + (long)lane * T.pitchK + 64 + (wid >> 1) * 8;
    const bf16_t* vsrc = Vh + (long)(16 * (wid & 3) + (lane >> 2)) * T.pitchV + (wid >> 2) * 32 + (lane & 3) * 8;
    const unsigned kdst = lds0 + LDS_K + wid * 1024, krdst = lds0 + LDS_K + (8 + (wid >> 1)) * 1024, vdst = lds0 + LDS_V + wid * 1024;
    const long kts = (long)64 * T.pitchK, vts = (long)64 * T.pitchV;
#define DMA_K(j, slot) do { glds16(ksrc + (long)(j) * kts, (unsigned)__builtin_amdgcn_readfirstlane(kdst + (slot) * KSLOT)); \
                           if (DQK == 96) glds16(krsrc + (long)(j) * kts, (unsigned)__builtin_amdgcn_readfirstlane(krdst + (slot) * KSLOT)); } while (0)
#define DMA_V(j, slot) glds16(vsrc + (long)(j) * vts, (unsigned)__builtin_amdgcn_readfirstlane(vdst + (slot) * VSLOT))
    const lds_cptr shm3 = (lds_cptr)shm;
    const lds_cptr kp0 = shm3 + LDS_K + hi * 1024 + r32 * 16;
    const lds_cptr vp0 = shm3 + LDS_V + ((lane >> 4) & 1) * 32 + (lane & 3) * 8 + (4 * hi + ((lane & 15) >> 2)) * 64;
    DMA_K(0, 0); DMA_K(1, 1); DMA_V(0, 0);
    if (SWA) {
        LAS float* tbl = (LAS float*)(shm + LDS_TB);
        for (int i = tid; i < TB_N; i += 512) tbl[i] = tb_g[i];
    }
    bf16x8 qr[ND];
#pragma unroll
    for (int d0 = 0; d0 < ND; ++d0) qr[d0] = *reinterpret_cast<const bf16x8*>(&Qw[(long)r32 * T.pitchQ + d0 * 16 + hi * 8]);
    float mhat = SWA ? sink2 : 0.f;
    float l_reg = (SWA && hi == 0) ? 1.0f : 0.f;
    f32x16 o[2]; o[0] = f32x16{}; o[1] = f32x16{};
    f32x16 negm;
#pragma unroll
    for (int r = 0; r < 16; ++r) negm[r] = -mhat;
    PIN(negm);
    f32x16 p0, p1; u32x4 pw0, pw1, pw2, pw3;
    pw0 = u32x4{0u, 0u, 0u, 0u}; pw1 = pw0; pw2 = pw0; pw3 = pw0;
    const int tb_idx0 = 64 * t_lo + 4 * hi - (q0 + 32 * wid + r32) + 383;
    WAIT_BAR(0);
    SBAR();
    if (grpB) { WAIT_BAR(0); SBAR(); }
    int sl_prev = 2, sl_cur = 0, sl_next = 1;
    for (int j = 0; j < NT; ++j) {
        if (j + 2 < NT) DMA_K(j + 2, sl_prev);
        if (j + 1 < NT) DMA_V(j + 1, sl_next);
        if (j > 0) {
            const lds_cptr vp = vp0 + sl_prev * VSLOT;
#pragma unroll
            for (int d0 = 0; d0 < 2; ++d0) {
#pragma unroll
                for (int ks = 0; ks < 4; ++ks) {
                    const s16x4 lo = vtr(vp + d0 * 4096 + ks * 1024), hh = vtr(vp + d0 * 4096 + ks * 1024 + 512);
                    const bf16x8 vf = (bf16x8){lo[0], lo[1], lo[2], lo[3], hh[0], hh[1], hh[2], hh[3]};
                    const u32x4 pw = ks == 0 ? pw0 : ks == 1 ? pw1 : ks == 2 ? pw2 : pw3;
                    o[d0] = MFMA32(__builtin_bit_cast(bf16x8, pw), vf, o[d0]);
                }
            }
        }
        {
            const lds_cptr kp = kp0 + sl_cur * KSLOT;
            f32x16 c0, c1;
            if (SWA) {
                const LAS float* tbl = (const LAS float*)(shm + LDS_TB) + (tb_idx0 + 64 * j);
#pragma unroll
                for (int r = 0; r < 16; ++r) { c0[r] = tbl[8 * (r >> 2) + (r & 3)] - mhat; c1[r] = tbl[32 + 8 * (r >> 2) + (r & 3)] - mhat; }
            } else { c0 = negm; c1 = negm; }
#pragma unroll
            for (int d0 = 0; d0 < ND; ++d0) {
                const bf16x8 k0 = *(const LAS bf16x8*)(kp + d0 * 2048), k1 = *(const LAS bf16x8*)(kp + d0 * 2048 + 512);
                if (d0 == 0) { p0 = MFMA32(k0, qr[0], c0); p1 = MFMA32(k1, qr[0], c1); }
                else { p0 = MFMA32(k0, qr[d0], p0); p1 = MFMA32(k1, qr[d0], p1); }
            }
        }
        SBAR();
        if (j + 2 < NT) { if (NBK == 2) WAIT_BAR(3); else WAIT_BAR(2); } else WAIT_BAR(0);
        SBAR();
        {
            const float rm = rowmax(p0, p1);
            const bool first = (!SWA) && (j == 0);
            bool resc = false;
            if (first || __any(rm > (float)THR)) {
                const float dl = first ? rm : __builtin_fmaxf(rm, 0.f);
                mhat += dl;
#pragma unroll
                for (int r = 0; r < 16; ++r) { p0[r] -= dl; p1[r] -= dl; }
#pragma unroll
                for (int r = 0; r < 16; ++r) negm[r] = -mhat;
                PIN(negm);
                if (!first) { const float f = __builtin_amdgcn_exp2f(-dl); l_reg *= f; if (hi == 0) wsf[r32] = f; resc = true; }
            }
            float sacc = 0.f;
#pragma unroll
            for (int r = 0; r < 16; ++r) { p0[r] = __builtin_amdgcn_exp2f(p0[r]); p1[r] = __builtin_amdgcn_exp2f(p1[r]); }
#pragma unroll
            for (int r = 0; r < 16; ++r) sacc += p0[r] + p1[r];
            l_reg += sacc;
            pw0 = (u32x4){cvt_pk_bf16(p0[0], p0[1]), cvt_pk_bf16(p0[2], p0[3]), cvt_pk_bf16(p0[4], p0[5]), cvt_pk_bf16(p0[6], p0[7])};
            pw1 = (u32x4){cvt_pk_bf16(p0[8], p0[9]), cvt_pk_bf16(p0[10], p0[11]), cvt_pk_bf16(p0[12], p0[13]), cvt_pk_bf16(p0[14], p0[15])};
            pw2 = (u32x4){cvt_pk_bf16(p1[0], p1[1]), cvt_pk_bf16(p1[2], p1[3]), cvt_pk_bf16(p1[4], p1[5]), cvt_pk_bf16(p1[6], p1[7])};
            pw3 = (u32x4){cvt_pk_bf16(p1[8], p1[9]), cvt_pk_bf16(p1[10], p1[11]), cvt_pk_bf16(p1[12], p1[13]), cvt_pk_bf16(p1[14], p1[15])};
            if (resc) {
#pragma unroll
                for (int r = 0; r < 16; ++r) { const float f = wsf[crow(r, hi)]; o[0][r] *= f; o[1][r] *= f; }
            }
            PIN(pw0); PIN(pw1); PIN(pw2); PIN(pw3); PIN(l_reg); PIN(o[0]); PIN(o[1]);
        }
        SBAR();
        if (j + 2 < NT) { if (NBK == 2) WAIT_BAR(3); else WAIT_BAR(2); } else WAIT_BAR(0);
        SBAR();
        { const int tmp = sl_prev; sl_prev = sl_cur; sl_cur = sl_next; sl_next = tmp; }
    }
    {
        const lds_cptr vp = vp0 + sl_prev * VSLOT;
#pragma unroll
        for (int d0 = 0; d0 < 2; ++d0) {
#pragma unroll
            for (int ks = 0; ks < 4; ++ks) {
                const s16x4 lo = vtr(vp + d0 * 4096 + ks * 1024), hh = vtr(vp + d0 * 4096 + ks * 1024 + 512);
                const bf16x8 vf = (bf16x8){lo[0], lo[1], lo[2], lo[3], hh[0], hh[1], hh[2], hh[3]};
                const u32x4 pw = ks == 0 ? pw0 : ks == 1 ? pw1 : ks == 2 ? pw2 : pw3;
                o[d0] = MFMA32(__builtin_bit_cast(bf16x8, pw), vf, o[d0]);
            }
        }
    }
    SBAR();
    if (!grpB) { WAIT_BAR(0); SBAR(); }
    { auto rr = __builtin_amdgcn_permlane32_swap(__float_as_uint(l_reg), __float_as_uint(l_reg), false, false); l_reg = __uint_as_float(rr[0]) + __uint_as_float(rr[1]); }
    if (hi == 0) wsf[32 + r32] = l_reg;
    float rli[16];
#pragma unroll
    for (int r = 0; r < 16; ++r) rli[r] = __builtin_amdgcn_rcpf(wsf[32 + crow(r, hi)]);
    {
        LAS bf16_t* stg = (LAS bf16_t*)(shm + LDS_OST) + wid * 2048;
#pragma unroll
        for (int r = 0; r < 16; ++r) { const int orow = crow(r, hi);
#pragma unroll
            for (int d0 = 0; d0 < 2; ++d0) { const unsigned w = cvt_pk_bf16(o[d0][r] * rli[r], 0.f); stg[orow * 64 + d0 * 32 + r32] = (bf16_t)(w & 0xffffu); } }
        const long orow0 = rowbase + q0 + wid * 32;
#pragma unroll
        for (int i = 0; i < 4; ++i) {
            const int row = i * 8 + (lane >> 3), ch = lane & 7;
            const u32x4 ov = *(const LAS u32x4*)(stg + row * 64 + ch * 8);
            const u32x4 gv = *(const u32x4*)(T.G + (orow0 + row) * T.pitchG + ocol + ch * 8);
            u32x4 res;
            res.x = cvt_pk_bf16(bf_lo(ov.x) * bf_lo(gv.x), bf_hi(ov.x) * bf_hi(gv.x));
            res.y = cvt_pk_bf16(bf_lo(ov.y) * bf_lo(gv.y), bf_hi(ov.y) * bf_hi(gv.y));
            res.z = cvt_pk_bf16(bf_lo(ov.z) * bf_lo(gv.z), bf_hi(ov.z) * bf_hi(gv.z));
            res.w = cvt_pk_bf16(bf_lo(ov.w) * bf_lo(gv.w), bf_hi(ov.w) * bf_hi(gv.w));
            *(u32x4*)(T.O + (orow0 + row) * T.pitchO + ocol + ch * 8) = res;
        }
    }
    SBAR();
    WAIT_BAR(0);
    SBAR();
#undef DMA_K
#undef DMA_V
}
#undef SBAR
#undef PIN
#undef MFMA32
#undef WAIT_BAR
#undef MX3
}

#define XB_TMO      128
#define XB_XCNT(j)  (256  + 64 * (j))
#define XB_XSUB(j)  (1280 + 64 * (j))
#define XB_XGEN(j)  (2304 + 64 * (j))
#define XB_TOP      3328
#define XB_TOPGEN   3392
#define XCD_BAR_WORDS 3456
#define XB_SPIN_CAP (1u << 18)

__device__ __forceinline__ unsigned xb_ld(unsigned* p)              { return __hip_atomic_load(p, __ATOMIC_RELAXED, __HIP_MEMORY_SCOPE_AGENT); }
__device__ __forceinline__ unsigned xb_add(unsigned* p, unsigned v) { return __hip_atomic_fetch_add(p, v, __ATOMIC_RELAXED, __HIP_MEMORY_SCOPE_AGENT); }
__device__ __forceinline__ unsigned xb_xcc_id() { return (unsigned)__builtin_amdgcn_s_getreg((3 << 11) | 20) & 0xFu; }
#define XB_SPIN(cond, bar) do { unsigned _sp = 0; while (cond) { __builtin_amdgcn_s_sleep(1); \
    if ((++_sp & 255u) == 0u) { if (xb_ld(&(bar)[XB_TMO])) break; if (_sp > XB_SPIN_CAP) { atomicAdd(&(bar)[XB_TMO], 1u); break; } } } } while (0)

struct XcdBarrier {
    unsigned* bar; unsigned x;
    volatile LAS unsigned* st;
};

__device__ __forceinline__ XcdBarrier xcd_barrier_post(unsigned* bar, volatile LAS unsigned* st) {
    XcdBarrier b; b.bar = bar; b.x = xb_xcc_id(); b.st = st;
    if (threadIdx.x == 0) (void)xb_add(&bar[XB_XCNT(b.x)], 1u);
    return b;
}
__device__ __forceinline__ void xcd_barrier_complete(unsigned* bar, unsigned x, unsigned& nloc, unsigned& nx) {
    const unsigned G = gridDim.x * gridDim.y * gridDim.z;
    unsigned sum, cnt, mine, sp = 0u;
    for (;;) {
        sum = 0u; cnt = 0u; mine = 0u;
#pragma unroll
        for (unsigned j = 0; j < 16; ++j) { const unsigned c = xb_ld(&bar[XB_XCNT(j)]); sum += c; cnt += (c > 0u) ? 1u : 0u; mine = (j == x) ? c : mine; }
        if (sum == G) break;
        __builtin_amdgcn_s_sleep(1);
        if ((++sp & 255u) == 0u) { if (xb_ld(&bar[XB_TMO])) break; if (sp > XB_SPIN_CAP) { atomicAdd(&bar[XB_TMO], 1u); break; } }
    }
    nloc = mine > 0u ? mine : 1u; nx = cnt > 0u ? cnt : 1u;
}

__device__ __forceinline__ void xcd_barrier(const XcdBarrier& b) {
    asm volatile("s_waitcnt vmcnt(0)" ::: "memory");
    __syncthreads();
    if (threadIdx.x == 0) {
        unsigned* bar = b.bar;
        __builtin_amdgcn_s_waitcnt(0);
        unsigned nloc = b.st[0], nx = b.st[1];
        if (nloc == 0u) { xcd_barrier_complete(bar, b.x, nloc, nx); b.st[0] = nloc; b.st[1] = nx; }
        const unsigned old = xb_add(&bar[XB_XSUB(b.x)], 1u);
        const unsigned gen = old / nloc;
        if (old + 1u == (gen + 1u) * nloc) {
            __builtin_amdgcn_fence(__ATOMIC_RELEASE, "agent");
            asm volatile("s_waitcnt vmcnt(0)" ::: "memory");
            const unsigned og = xb_add(&bar[XB_TOP], 1u);
            const unsigned tg = og / nx;
            if (og + 1u == (tg + 1u) * nx) xb_add(&bar[XB_TOPGEN], 1u);
            else XB_SPIN(xb_ld(&bar[XB_TOPGEN]) == tg, bar);
            __builtin_amdgcn_fence(__ATOMIC_ACQUIRE, "agent");
            xb_add(&bar[XB_XGEN(b.x)], 1u);
            asm volatile("s_waitcnt vmcnt(0)" ::: "memory");
        } else {
            XB_SPIN(xb_ld(&bar[XB_XGEN(b.x)]) == gen, bar);
            __builtin_amdgcn_fence(__ATOMIC_ACQUIRE, "agent");
            asm volatile("s_waitcnt vmcnt(0)" ::: "memory");
        }
    }
    __syncthreads();
}

constexpr int NWAVES = 8;
constexpr size_t MiB = 1u << 20;
constexpr size_t WS_CTL = 0, CTL_ZERO_BYTES = 1 * MiB;
constexpr size_t WS_WIN = 2 * MiB;
constexpr size_t WS_WUP = 7 * MiB;
constexpr size_t WS_WOUT = 8 * MiB;
constexpr size_t WS_CS = 10 * MiB;
constexpr size_t WS_TB = 11 * MiB;
constexpr size_t WS_SSQ = 12 * MiB;
constexpr size_t WS_XB = 16 * MiB;
constexpr size_t WS_PROJ = 80 * MiB;
constexpr size_t WS_QM = 224 * MiB;
constexpr size_t WS_KM = 272 * MiB;
constexpr size_t WS_VM = 320 * MiB;
constexpr size_t WS_MIX = 352 * MiB;
constexpr size_t WS_END = 416 * MiB;
constexpr int CW_BAR = 4096;
static_assert((CW_BAR + XCD_BAR_WORDS) * 4 <= (int)CTL_ZERO_BYTES, "CTL words inside the memset region");
constexpr int RING_OFF = 0, RING_BYTES = 131072;
constexpr int LDSCTL_OFF = RING_BYTES, MISC_OFF = LDSCTL_OFF + 320;
constexpr int LDS_BYTES = 147456;
static_assert(attn::LDS_BYTES <= RING_BYTES && pg8::STAGE_BYTES <= RING_BYTES, "phase scratch fits the ring region");

struct Args { const float* x; const float* w_in; const float* g_q; const float* g_kv; const float* w_uq; const float* w_ukv; const float* sink; const float* rel_bias;
              const float* w_out; const float* ln_g; const float* ln_b; float* out; unsigned char* ws; };

__device__ __forceinline__ float wave_sum(float v) {
#pragma unroll
    for (int o = 1; o < 64; o <<= 1) v += __shfl_xor(v, o);
    return v;
}
__device__ __forceinline__ int map_col(int kind, int n) {
    if (kind == 0) {
        if (n < 384) return n;
        if (n < 416) { const int e = n - 384; return SC_KR + (e >> 1) + 16 * (e & 1); }
        if (n < 512) return -1;
        if (n < 1024) return SC_GA + (n - 512);
        if (n < 1536) return SC_QS + (n - 1024);
        if (n < 1664) return SC_KS + (n - 1536);
        if (n < 1792) return SC_VS + (n - 1664);
        return SC_GB + (n - 1792);
    } else if (kind == 1) {
        const int h = n / 96, d = n % 96; if (d < 64) return n; const int e = d - 64; return h * 96 + 64 + (e >> 1) + 16 * (e & 1);
    } else if (kind == 2) {
        if (n < 512) return (n >> 6) * 128 + (n & 63);
        const int c = n - 512; return (c >> 6) * 128 + 64 + (c & 63);
    }
    return n;
}
__device__ __forceinline__ void tr_item(const float* W, int Nsrc, int Kvalid, bf16_t* WT, int ldt, int drow, int k0, int nloc0, int kind, const float* kscale, LAS float* scr, int lane) {
    const int sc = map_col(kind, nloc0 + (lane & 31));
#pragma unroll 8
    for (int i = 0; i < 32; ++i) { const int kk = 2 * i + (lane >> 5), k = k0 + kk; float v = 0.f;
        if (sc >= 0 && k < Kvalid) { v = W[(size_t)k * Nsrc + sc]; if (kscale) v *= kscale[k]; }
        scr[kk * 33 + (lane & 31)] = v; }
    asm volatile("s_waitcnt lgkmcnt(0)" ::: "memory");
    const int c = lane & 7;
#pragma unroll
    for (int j = 0; j < 4; ++j) { const int n = (lane >> 3) + 8 * j; const LAS float* s = scr + (8 * c) * 33 + n;
        u32x4 o; o.x = cvt_pk_bf16(s[0 * 33], s[1 * 33]); o.y = cvt_pk_bf16(s[2 * 33], s[3 * 33]); o.z = cvt_pk_bf16(s[4 * 33], s[5 * 33]); o.w = cvt_pk_bf16(s[6 * 33], s[7 * 33]);
        *(u32x4*)(WT + (size_t)(drow + nloc0 + n) * ldt + k0 + 8 * c) = o; }
    asm volatile("s_waitcnt lgkmcnt(0)" ::: "memory");
}
__device__ __forceinline__ int t5_bucket(int rel) {
    const int n = rel < 0 ? -rel : rel;
    int s = n;
    if (n >= 8) { s = 8 + (n >= 12) + (n >= 16) + (n >= 23) + (n >= 32) + (n >= 46) + (n >= 64) + (n >= 91); if (s > 15) s = 15; }
    return (rel > 0 ? 16 : 0) + s;
}

__global__ void __launch_bounds__(NWAVES * 64, 2) fwd_kernel(Args args) {
    extern __shared__ __attribute__((aligned(16))) unsigned char lds[];
    LAS unsigned char* L = (LAS unsigned char*)lds;
    volatile LAS unsigned* MISC = (volatile LAS unsigned*)(L + MISC_OFF);
    const int G = gridDim.x, bx = blockIdx.x;
    const int vcu = (G % 8 == 0) ? (bx % 8) * (G / 8) + bx / 8 : bx;
    unsigned* ctl = (unsigned*)(args.ws + WS_CTL);
#define WS_PTRS() unsigned char* ws = args.ws; asm volatile("" : "+s"(ws));
    for (int u = threadIdx.x; u < (LDS_BYTES - LDSCTL_OFF) / 4; u += NWAVES * 64) ((LAS unsigned*)(L + LDSCTL_OFF))[u] = 0u;
    __syncthreads();
    XcdBarrier bar = xcd_barrier_post(ctl + CW_BAR, MISC + 8);

    {
        const int tid = fresh_tid(), lane = tid & 63, wave = __builtin_amdgcn_readfirstlane(tid >> 6);
        WS_PTRS(); bf16_t* Win_t = (bf16_t*)(ws + WS_WIN); bf16_t* Wup_t = (bf16_t*)(ws + WS_WUP); bf16_t* Wout_t = (bf16_t*)(ws + WS_WOUT);
        float* CS = (float*)(ws + WS_CS); float* TB = (float*)(ws + WS_TB); bf16_t* XB = (bf16_t*)(ws + WS_XB);
        LAS float* scr = (LAS float*)(L + RING_OFF + wave * 16384);
        const int gw = vcu * NWAVES + wave, NGW = G * NWAVES;
        constexpr int I_IN = 16 * 72, I_UQ = 4 * 24, I_UKV = 4 * 32, I_OUT = 16 * 32, NITEMS = I_IN + I_UQ + I_UKV + I_OUT;
        for (int it = gw; it < NITEMS; it += NGW) {
            int r = it;
            if (r < I_IN) { tr_item(args.w_in, D_IN, 1024, Win_t, 1024, 0, 64 * (r / 72), 32 * (r % 72), 0, nullptr, scr, lane); continue; } r -= I_IN;
            if (r < I_UQ) { tr_item(args.w_uq, 768, 256, Wup_t, 256, 0, 64 * (r / 24), 32 * (r % 24), 1, args.g_q, scr, lane); continue; } r -= I_UQ;
            if (r < I_UKV) { tr_item(args.w_ukv, 1024, 128, Wup_t, 256, 768, 64 * (r / 32), 32 * (r % 32), 2, args.g_kv, scr, lane); continue; } r -= I_UKV;
            tr_item(args.w_out, 1024, 1024, Wout_t, 1024, 0, 64 * (r / 32), 32 * (r % 32), 3, nullptr, scr, lane);
        }
        for (int m = gw; m < MTOK; m += NGW) {
            const GAS f32x4* xr = (const GAS f32x4*)(args.x + (size_t)m * DMODEL) + lane;
            GAS u32x2* o8 = (GAS u32x2*)(XB + (size_t)m * DMODEL) + lane;
            f32x4 v[4];
#pragma unroll
            for (int j = 0; j < 4; ++j) v[j] = xr[64 * j];
#pragma unroll
            for (int j = 0; j < 4; ++j) { u32x2 w; w.x = cvt_pk_bf16(v[j][0], v[j][1]); w.y = cvt_pk_bf16(v[j][2], v[j][3]); o8[64 * j] = w; }
        }
        for (int e = vcu * (NWAVES * 64) + tid; e < SEQ * 16; e += G * NWAVES * 64) {
            const int pos = e >> 4, i = e & 15;
            const float inv = (float)pow(10000.0, -(double)(2 * i) / 32.0);
            const float ang = (float)pos * inv;
            CS[pos * 32 + i] = (float)cos((double)ang); CS[pos * 32 + 16 + i] = (float)sin((double)ang);
        }
        for (int e = vcu * (NWAVES * 64) + tid; e < 8 * TB_N; e += G * NWAVES * 64) {
            const int h = e / TB_N, idx = e % TB_N, rel = idx - 383;
            float v = NEG_BIG;
            if (rel >= -128 && rel <= 128) v = args.rel_bias[t5_bucket(rel) * 8 + h] * LOG2E;
            TB[e] = v;
        }
    }
    xcd_barrier(bar);

    {
        WS_PTRS();
        pg8::Gemm g{(const bf16_t*)(ws + WS_XB), (const bf16_t*)(ws + WS_WIN)};
        pg8::StaticOrder S; S.init(MTOK / 256, NPROJ / 256, G, bx);
        pg8::EpiProj E{(bf16_t*)(ws + WS_PROJ), (bf16_t*)(ws + WS_KM), (float*)(ws + WS_SSQ), (const float*)(ws + WS_CS)};
        pg8::gemm_phase<pg8::GemmCfg<1024, 1024, 1024, 1 << 20, 0>, pg8::EpiProj, true>(L + RING_OFF, g, S, E);
    }
    xcd_barrier(bar);

    {
        WS_PTRS();
        pg8::Gemm g{(const bf16_t*)(ws + WS_PROJ), (const bf16_t*)(ws + WS_WUP)};
        pg8::StaticOrder S; S.init(MTOK / 256, NUP / 256, G, bx);
        pg8::EpiUp E{(bf16_t*)(ws + WS_QM), (bf16_t*)(ws + WS_KM), (bf16_t*)(ws + WS_VM), (const float*)(ws + WS_SSQ), (const float*)(ws + WS_CS)};
        pg8::gemm_phase<pg8::GemmCfg<NPROJ, 256, 256, 3, 256>, pg8::EpiUp, true>(L + RING_OFF, g, S, E);
    }
    xcd_barrier(bar);

    {
        WS_PTRS(); bf16_t* PROJ = (bf16_t*)(ws + WS_PROJ); bf16_t* Qm = (bf16_t*)(ws + WS_QM); bf16_t* Km = (bf16_t*)(ws + WS_KM); bf16_t* Vm = (bf16_t*)(ws + WS_VM);
        bf16_t* MIX = (bf16_t*)(ws + WS_MIX); const float* TB = (const float*)(ws + WS_TB);
        const unsigned lds0 = (unsigned)(uintptr_t)lds + RING_OFF;
        attn::Tensors TA{Qm, QM_PITCH, Km, KM_PITCH, Vm, VM_PITCH, PROJ + PC_GA, NPROJ, MIX, MIX_PITCH};
        for (int uid = vcu; uid < 1024; uid += G) {
            const int bh = uid >> 5, qb = uid & 31, b = bh >> 3, h = bh & 7;
            attn::attn_unit<96, false, 8>(TA, b, h * 96, h * 96, h * 64, h * 64, qb, L + RING_OFF, lds0, nullptr, 0.f);
        }
        attn::Tensors TS{PROJ + PC_QS, NPROJ, PROJ + PC_KS, NPROJ, PROJ + PC_VS, NPROJ, PROJ + PC_GB, NPROJ, MIX + 512, MIX_PITCH};
        for (int uid = vcu; uid < 1024; uid += G) {
            const int bh = uid >> 5, qb = uid & 31, b = bh >> 3, h = bh & 7;
            attn::attn_unit<64, true, 8>(TS, b, h * 64, (h >> 2) * 64, (h >> 2) * 64, h * 64, qb, L + RING_OFF, lds0, TB + h * TB_N, args.sink[h] * LOG2E);
        }
    }
    xcd_barrier(bar);

    {
        WS_PTRS();
        pg8::Gemm g{(const bf16_t*)(ws + WS_MIX), (const bf16_t*)(ws + WS_WOUT)};
        pg8::StaticOrder S; S.init(MTOK / 256, DMODEL / 256, G, bx);
        pg8::EpiOut E{args.x, args.out};
        pg8::gemm_phase<pg8::GemmCfg<1024, 1024, 1024, 1 << 20, 0>, pg8::EpiOut, true>(L + RING_OFF, g, S, E);
    }
    xcd_barrier(bar);

    {
        const int tid = fresh_tid(), lane = tid & 63, wave = __builtin_amdgcn_readfirstlane(tid >> 6);
        const int gw = vcu * NWAVES + wave, NGW = G * NWAVES;
        f32x4 gv[4], bv[4];
#pragma unroll
        for (int j = 0; j < 4; ++j) { gv[j] = ((const f32x4*)args.ln_g)[64 * j + lane]; bv[j] = ((const f32x4*)args.ln_b)[64 * j + lane]; }
        for (int m = gw; m < MTOK; m += NGW) {
            GAS f32x4* xr = (GAS f32x4*)(args.out + (size_t)m * DMODEL) + lane;
            f32x4 v[4]; float s = 0.f;
#pragma unroll
            for (int j = 0; j < 4; ++j) { v[j] = xr[64 * j]; s += (v[j][0] + v[j][1]) + (v[j][2] + v[j][3]); }
            const float mean = wave_sum(s) * (1.f / DMODEL); float s2 = 0.f;
#pragma unroll
            for (int j = 0; j < 4; ++j) { v[j] = v[j] - mean; s2 += (v[j][0] * v[j][0] + v[j][1] * v[j][1]) + (v[j][2] * v[j][2] + v[j][3] * v[j][3]); }
            const float rstd = 1.f / sqrtf(wave_sum(s2) * (1.f / DMODEL) + LN_EPS);
#pragma unroll
            for (int j = 0; j < 4; ++j) xr[64 * j] = v[j] * rstd * gv[j] + bv[j];
        }
    }
}

extern "C" void kernel_launch(void* const* d_in, const int* in_sizes, int n_in, void* d_out, int out_size, void* d_ws, size_t ws_size, hipStream_t stream) {
    static int grid = 0;
    if (grid == 0) {
        if (n_in != 11 || in_sizes[0] != MTOK * DMODEL || out_size != MTOK * DMODEL || ws_size < WS_END) {
            fprintf(stderr, "kernel_launch: unexpected shapes (n_in %d, in0 %d, out %d, ws %zu); nothing launched\n", n_in, n_in > 0 ? in_sizes[0] : -1, out_size, ws_size); grid = -1; return; }
        int dev = 0, cus = 0;
        if (hipGetDevice(&dev) != hipSuccess || hipDeviceGetAttribute(&cus, hipDeviceAttributeMultiprocessorCount, dev) != hipSuccess) { fprintf(stderr, "kernel_launch: device query failed\n"); grid = -1; return; }
        if (hipFuncSetAttribute((const void*)fwd_kernel, hipFuncAttributeMaxDynamicSharedMemorySize, LDS_BYTES) != hipSuccess) { fprintf(stderr, "kernel_launch: hipFuncSetAttribute failed\n"); grid = -1; return; }
        (void)hipGetLastError();
        grid = cus;
    }
    if (grid < 0) return;
    if (hipMemsetAsync((char*)d_ws + WS_CTL, 0, CTL_ZERO_BYTES, stream) != hipSuccess) { fprintf(stderr, "kernel_launch: hipMemsetAsync failed\n"); return; }
    Args a{};
    a.x = (const float*)d_in[0]; a.w_in = (const float*)d_in[1]; a.g_q = (const float*)d_in[2]; a.g_kv = (const float*)d_in[3]; a.w_uq = (const float*)d_in[4]; a.w_ukv = (const float*)d_in[5];
    a.sink = (const float*)d_in[6]; a.rel_bias = (const float*)d_in[7]; a.w_out = (const float*)d_in[8]; a.ln_g = (const float*)d_in[9]; a.ln_b = (const float*)d_in[10];
    a.out = (float*)d_out; a.ws = (unsigned char*)d_ws;
    hipLaunchKernelGGL(fwd_kernel, dim3(grid), dim3(NWAVES * 64), LDS_BYTES, stream, a);
    const hipError_t le = hipPeekAtLastError();
    if (le != hipSuccess) fprintf(stderr, "kernel_launch: launch failed: %s\n", hipGetErrorName(le));
}
```

```cpp
#include <hip/hip_runtime.h>
#include <cstdio>
#include <cstdint>
#include <cmath>

constexpr int NBATCH = 4, SEQ = 8192, DMODEL = 1024, MTOK = NBATCH * SEQ;
constexpr int D_IN = 2208;
constexpr int NPROJ = 2304;
constexpr int PC_CQ = 0;           constexpr int SC_CQ = 0;
constexpr int PC_CKV = 256;        constexpr int SC_CKV = 256;
constexpr int PC_KR = 384;         constexpr int SC_KR = 384;
constexpr int PC_GA = 512;         constexpr int SC_GA = 416;
constexpr int PC_QS = 1024;        constexpr int SC_QS = 928;
constexpr int PC_KS = 1536;        constexpr int SC_KS = 1440;
constexpr int PC_VS = 1664;        constexpr int SC_VS = 1568;
constexpr int PC_GB = 1792;        constexpr int SC_GB = 1696;
constexpr int QM_PITCH = 768, KM_PITCH = 768, VM_PITCH = 512, MIX_PITCH = 1024;
constexpr int NUP = 1792;
constexpr float LOG2E = 1.4426950408889634f;
constexpr float MLA_QSCALE = 0.10206207261596575f * LOG2E;
constexpr float SWA_QSCALE = 0.125f * LOG2E;
constexpr float ALPHA_RES = 1.189207115002721f;
constexpr float RMS_EPS = 1e-6f, LN_EPS = 1e-5f;
constexpr int TB_N = 768;
constexpr float NEG_BIG = -1.0e30f;

#define GAS __attribute__((address_space(1)))
#define LAS __attribute__((address_space(3)))
typedef unsigned short bf16_t;
typedef short bf16x8 __attribute__((ext_vector_type(8)));
typedef short s16x4 __attribute__((ext_vector_type(4)));
typedef float f32x4 __attribute__((ext_vector_type(4)));
typedef float f32x2 __attribute__((ext_vector_type(2)));
typedef float f32x16 __attribute__((ext_vector_type(16)));
typedef unsigned u32x4 __attribute__((ext_vector_type(4)));
typedef unsigned u32x2 __attribute__((ext_vector_type(2)));
typedef __bf16 bf16x2_t __attribute__((ext_vector_type(2)));

__device__ __forceinline__ unsigned cvt_pk_bf16(float lo, float hi) { f32x2 v = {lo, hi}; bf16x2_t b = __builtin_convertvector(v, bf16x2_t); return __builtin_bit_cast(unsigned, b); }
__device__ __forceinline__ float bf_lo(unsigned w) { return __uint_as_float(w << 16); }
__device__ __forceinline__ float bf_hi(unsigned w) { return __uint_as_float(w & 0xffff0000u); }
__device__ __forceinline__ int fresh_tid() { int t = threadIdx.x; asm volatile("" : "+v"(t)); return t; }
__device__ __forceinline__ float silu_f(float x) { return x * __builtin_amdgcn_rcpf(1.0f + __builtin_amdgcn_exp2f(-x * LOG2E)); }

namespace pg8 {
constexpr int BM = 256, BK = 64, HALF = 128, HTB = HALF * BK * 2  , STAGE_BYTES = 8 * HTB, NXCD = 8, WGM = 8;
__host__ __device__ __forceinline__ int lds_byte(int r, int c) { const int st = (r >> 4) * 2 + (c >> 5), rr = r & 15, cc = c & 31, ob = rr * 64 + cc * 2; return st * 1024 + (ob ^ (((ob >> 9) & 1) << 5)); }
__host__ __device__ __forceinline__ void stage_rc(int b, int& R, int& C) { const int st = b / 1024, sb = b % 1024, swz = sb ^ (((sb >> 9) & 1) << 5); R = (st >> 1) * 16 + swz / 64; C = (st & 1) * 32 + (swz % 64) / 2; }
__host__ __device__ __forceinline__ int perm32(int rho) { const int n = rho >> 4, i = rho & 15; return 8 * (i >> 2) + 4 * n + (i & 3); }

struct Unit { int pm, pn; };
struct Gemm { const bf16_t* A; const bf16_t* Bt; };
template <int LDA_, int LDB_, int K_, int PN_SPLIT_, int A_OFF2_> struct GemmCfg { static constexpr int LDA = LDA_, LDB = LDB_, K = K_, PN_SPLIT = PN_SPLIT_, A_OFF2 = A_OFF2_; };

struct StaticOrder {
    int nM, nN, nwg, G, c;
    __device__ void init(int nM_, int nN_, int G_, int c_) { nM = nM_; nN = nN_; nwg = nM * nN; G = G_; c = c_; }
    __device__ bool next(int i, Unit& u) const {
        const long L = (long)i * G + c; if (L >= nwg) return false;
        int wgid = (int)L; { const int q = nwg / NXCD, r = nwg % NXCD, xcd = wgid % NXCD, off = wgid / NXCD; wgid = (xcd < r ? xcd * (q + 1) : r * (q + 1) + (xcd - r) * q) + off; }
        const int nig = WGM * nN, gid = wgid / nig, fm = gid * WGM, gsz = (nM - fm) < WGM ? (nM - fm) : WGM;
        u.pm = fm + ((wgid % nig) % gsz); u.pn = (wgid % nig) / gsz; return true;
    }
};


__device__ __forceinline__ void rope8(f32x4& v0, f32x4& v1, const float* cs, int i0) {
    const f32x4 c = *(const f32x4*)(cs + i0), s = *(const f32x4*)(cs + 16 + i0);
    const float a0 = v0[0], b0 = v0[1], a1 = v0[2], b1 = v0[3], a2 = v1[0], b2 = v1[1], a3 = v1[2], b3 = v1[3];
    v0[0] = a0 * c[0] - b0 * s[0]; v0[1] = b0 * c[0] + a0 * s[0];
    v0[2] = a1 * c[1] - b1 * s[1]; v0[3] = b1 * c[1] + a1 * s[1];
    v1[0] = a2 * c[2] - b2 * s[2]; v1[1] = b2 * c[2] + a2 * s[2];
    v1[2] = a3 * c[3] - b3 * s[3]; v1[3] = b3 * c[3] + a3 * s[3];
}
__device__ __forceinline__ u32x4 pack8(const f32x4& v0, const f32x4& v1) { u32x4 w; w.x = cvt_pk_bf16(v0[0], v0[1]); w.y = cvt_pk_bf16(v0[2], v0[3]); w.z = cvt_pk_bf16(v1[0], v1[1]); w.w = cvt_pk_bf16(v1[2], v1[3]); return w; }

struct EpiProj {
    static constexpr bool PERM = true;
    bf16_t* PROJ; bf16_t* Km; bf16_t* KSB; bf16_t* VSB; float* SSQ; const float* CS;
    __device__ __forceinline__ void operator()(const f32x4 (&acc)[2][2][4][2], const Unit& u, int wr, int wc, int fr, int fq) const {
        asm volatile("" : "+v"(fr), "+v"(fq));
        const int pn = u.pn;
        const int row0 = u.pm * BM + wr * 64 + fr;
        const int col0 = pn * BM + wc * 32 + 8 * fq;
        int mode[2];
#pragma unroll
        for (int bj = 0; bj < 2; ++bj) {
            int md = 0;
            if (pn == 0) md = 1;
            else if (pn == 1) md = (bj == 0) ? 1 : ((wc == 0) ? 4 : 0);
            else if (pn == 2 || pn == 3 || pn >= 7) md = 2;
            else if (pn == 4 || pn == 5) md = 3;
            mode[bj] = md;
        }
#pragma unroll
        for (int ai = 0; ai < 2; ++ai)
#pragma unroll
            for (int m = 0; m < 4; ++m) {
                const int row = row0 + ai * HALF + m * 16;
                bf16_t* rowp = PROJ + (size_t)row * NPROJ + col0;
                float ss = 0.f;
#pragma unroll
                for (int bj = 0; bj < 2; ++bj) {
                    f32x4 v0 = acc[ai][bj][m][0], v1 = acc[ai][bj][m][1];
                    const int md = mode[bj];
                    if (md == 1) { ss += (v0[0] * v0[0] + v0[1] * v0[1]) + (v0[2] * v0[2] + v0[3] * v0[3]) + (v1[0] * v1[0] + v1[1] * v1[1]) + (v1[2] * v1[2] + v1[3] * v1[3]); }
                    else if (md == 2) {
#pragma unroll
                        for (int e = 0; e < 4; ++e) { v0[e] = silu_f(v0[e]); v1[e] = silu_f(v1[e]); }
                    } else if (md == 3) { v0 = v0 * SWA_QSCALE; v1 = v1 * SWA_QSCALE; }
                    else if (md == 4) { rope8(v0, v1, CS + (size_t)(row & (SEQ - 1)) * 32, 4 * fq); }
                    const u32x4 w = pack8(v0, v1);
                    const int bb = row >> 13, tile = (row >> 6) & 127, rr = row & 63;
                    if (pn == 6) {
                        const int c = wc * 32 + 8 * fq, kvh = c >> 6, d = c & 63;
                        if (bj == 0) *(u32x4*)(KSB + ((size_t)((bb * 2 + kvh) * 128 + tile) * 8 + (d >> 3)) * 512 + rr * 8) = w;
                        else *(u32x4*)(VSB + ((size_t)((bb * 2 + kvh) * 128 + tile) * 2 + (d >> 5)) * 2048 + rr * 32 + (d & 31)) = w;
                    } else *(u32x4*)(rowp + bj * HALF) = w;
                    if (md == 4) {
#pragma unroll
                        for (int h = 0; h < 8; ++h) *(u32x4*)(Km + ((size_t)((bb * 8 + h) * 128 + tile) * 12 + 8 + fq) * 512 + rr * 8) = w;
                    }
                }
                if (pn <= 1) {
                    ss += __shfl_xor(ss, 16); ss += __shfl_xor(ss, 32);
                    if (fq == 0) SSQ[(size_t)row * 8 + pn * 4 + wc] = ss;
                }
                asm volatile("" ::: "memory");
            }
    }
};

struct EpiUp {
    static constexpr bool PERM = true;
    bf16_t* Qm; bf16_t* Km; bf16_t* Vm; const float* SSQ; const float* CS;
    __device__ __forceinline__ void operator()(const f32x4 (&acc)[2][2][4][2], const Unit& u, int wr, int wc, int fr, int fq) const {
        asm volatile("" : "+v"(fr), "+v"(fq));
        const int pn = u.pn;
        const int row0 = u.pm * BM + wr * 64 + fr;
        const bool isq = pn < 3;
#pragma unroll
        for (int ai = 0; ai < 2; ++ai)
#pragma unroll
            for (int m = 0; m < 4; ++m) {
                const int row = row0 + ai * HALF + m * 16;
                const f32x4 s4 = *(const f32x4*)(SSQ + (size_t)row * 8 + (isq ? 0 : 4));
                const float ssum = (s4[0] + s4[1]) + (s4[2] + s4[3]);
                const float rstd = 1.0f / sqrtf(ssum * (isq ? (1.0f / 256.0f) : (1.0f / 128.0f)) + RMS_EPS);
                const float sc = isq ? rstd * MLA_QSCALE : rstd;
#pragma unroll
                for (int bj = 0; bj < 2; ++bj) {
                    f32x4 v0 = acc[ai][bj][m][0] * sc, v1 = acc[ai][bj][m][1] * sc;
                    bf16_t* dst;
                    if (isq) {
                        const int blk = 8 * pn + 4 * bj + wc;
                        if (blk % 3 == 2) rope8(v0, v1, CS + (size_t)(row & (SEQ - 1)) * 32, 4 * fq);
                        dst = Qm + (size_t)row * QM_PITCH + pn * BM + bj * HALF + wc * 32 + 8 * fq;
                    } else if (pn < 5) {
                        const int c = (pn - 3) * BM + bj * HALF + wc * 32 + 8 * fq, h = c >> 6, d = c & 63;
                        const int bb = row >> 13, tile = (row >> 6) & 127, rr = row & 63;
                        dst = Km + ((size_t)((bb * 8 + h) * 128 + tile) * 12 + (d >> 3)) * 512 + rr * 8;
                    } else {
                        const int c = (pn - 5) * BM + bj * HALF + wc * 32 + 8 * fq, h = c >> 6, d = c & 63;
                        const int bb = row >> 13, tile = (row >> 6) & 127, rr = row & 63;
                        dst = Vm + ((size_t)((bb * 8 + h) * 128 + tile) * 2 + (d >> 5)) * 2048 + rr * 32 + (d & 31);
                    }
                    *(u32x4*)dst = pack8(v0, v1);
                }
                asm volatile("" ::: "memory");
            }
    }
};

struct EpiOut {
    static constexpr bool PERM = false;
    const float* X; float* OUT;
    __device__ __forceinline__ void operator()(const f32x4 (&acc)[2][2][4][2], const Unit& u, int wr, int wc, int fr, int fq) const {
        asm volatile("" : "+v"(fr), "+v"(fq));
        const int row0 = u.pm * BM + wr * 64 + fr;
        const int col0 = u.pn * BM + wc * 32 + 4 * fq;
#pragma unroll
        for (int ai = 0; ai < 2; ++ai)
#pragma unroll
            for (int m = 0; m < 4; ++m) {
                const size_t off = (size_t)(row0 + ai * HALF + m * 16) * DMODEL + col0;
#pragma unroll
                for (int bj = 0; bj < 2; ++bj)
#pragma unroll
                    for (int n = 0; n < 2; ++n) {
                        const f32x4 xv = *(const f32x4*)(X + off + bj * HALF + n * 16);
                        *(f32x4*)(OUT + off + bj * HALF + n * 16) = xv * ALPHA_RES + acc[ai][bj][m][n];
                    }
            }
    }
};

template <class Cfg, class Epi, bool ALIGN_EPI>
__device__ __forceinline__ void gemm_phase(LAS unsigned char* lds, const Gemm g, const StaticOrder& S, const Epi& E) {
    const int tid = fresh_tid(), wid = __builtin_amdgcn_readfirstlane(tid >> 6), lane = tid & 63, wr = wid >> 2, wc = wid & 3, fr = lane & 15, fq = lane >> 4;
    constexpr int nt = Cfg::K / BK;
    unsigned voffA[2], voffB[2];
#pragma unroll
    for (int i = 0; i < 2; ++i) { int R, C; stage_rc(tid * 16 + i * 8192, R, C); const int Rb = Epi::PERM ? ((R & ~31) + perm32(R & 31)) : R;
        voffA[i] = (unsigned)(R * Cfg::LDA + C) * 2u; voffB[i] = (unsigned)(Rb * Cfg::LDB + C) * 2u; }
    const size_t kstep = (size_t)(BK * 2);
    constexpr size_t hA = (size_t)HALF * Cfg::LDA * 2, hB = (size_t)HALF * Cfg::LDB * 2;
    constexpr size_t tA = 2 * hA, tB = 2 * hB;
    const unsigned ldsw = (unsigned)wid * 1024u;
    const int aoff = lds_byte(wr * 64 + fr, fq * 8), boff = lds_byte(wc * 32 + fr, fq * 8);
#define PG8_SA(b, h) (((b) * 2 + (h)) * HTB)
#define PG8_SB(b, h) ((4 + (b) * 2 + (h)) * HTB)
#define PG8_STAGE(bufoff, gbase, voff) do { _Pragma("unroll") for (int _i = 0; _i < 2; ++_i) \
        __builtin_amdgcn_global_load_lds((const unsigned*)((const char*)(gbase) + (voff)[_i]), (LAS unsigned*)(lds + (bufoff) + ldsw + _i * 8192), 16, 0, 0); } while (0)
#define PG8_LDA(dst, b, h) do { _Pragma("unroll") for (int m = 0; m < 4; ++m) _Pragma("unroll") for (int k = 0; k < 2; ++k) dst[m][k] = *(const LAS bf16x8*)(lds + PG8_SA(b, h) + aoff + m * 2048 + k * 1024); } while (0)
#define PG8_LDB(dst, b, h) do { _Pragma("unroll") for (int n = 0; n < 2; ++n) _Pragma("unroll") for (int k = 0; k < 2; ++k) dst[n][k] = *(const LAS bf16x8*)(lds + PG8_SB(b, h) + boff + n * 2048 + k * 1024); } while (0)
#define PG8_MMA(ai, bj, At, Bt) do { __builtin_amdgcn_s_setprio(1); _Pragma("unroll") for (int m = 0; m < 4; ++m) _Pragma("unroll") for (int n = 0; n < 2; ++n) _Pragma("unroll") for (int k = 0; k < 2; ++k) \
        acc[ai][bj][m][n] = __builtin_amdgcn_mfma_f32_16x16x32_bf16(Bt[n][k], At[m][k], acc[ai][bj][m][n], 0, 0, 0); __builtin_amdgcn_s_setprio(0); } while (0)
#define PG8_WAIT_V(n) asm volatile("s_waitcnt vmcnt(" #n ")" ::: "memory")
#define PG8_WAIT_L(n) asm volatile("s_waitcnt lgkmcnt(" #n ")" ::: "memory")
#define PG8_BAR __builtin_amdgcn_s_barrier()
#define PG8_SCHED __builtin_amdgcn_sched_barrier(0)
#define PG8_ABASE(u) ((const char*)g.A + (size_t)(u).pm * tA + ((u).pn >= Cfg::PN_SPLIT ? (size_t)Cfg::A_OFF2 * 2 : (size_t)0))
#define PG8_BBASE(u) ((const char*)g.Bt + (size_t)(u).pn * tB)
    Unit cur, nxt; int ui = 0;
    if (!S.next(0, cur)) return;
    f32x4 acc[2][2][4][2];
#pragma unroll
    for (int a = 0; a < 2; ++a)
#pragma unroll
        for (int b = 0; b < 2; ++b)
#pragma unroll
            for (int m = 0; m < 4; ++m)
#pragma unroll
                for (int n = 0; n < 2; ++n) acc[a][b][m][n] = (f32x4){0.f, 0.f, 0.f, 0.f};
    bf16x8 At[4][2], B0[2][2], B1[2][2];
    const char* cA = PG8_ABASE(cur); const char* cB = PG8_BBASE(cur);
    PG8_STAGE(PG8_SB(0, 0), cB, voffB); PG8_STAGE(PG8_SB(0, 1), cB + hB, voffB); PG8_STAGE(PG8_SA(0, 0), cA, voffA); PG8_STAGE(PG8_SA(0, 1), cA + hA, voffA);
    if (wr == 1) PG8_BAR;
    PG8_WAIT_V(2); PG8_BAR;
    PG8_STAGE(PG8_SB(1, 0), cB + kstep, voffB); PG8_STAGE(PG8_SA(1, 0), cA + kstep, voffA); PG8_STAGE(PG8_SB(1, 1), cB + hB + kstep, voffB);
    PG8_WAIT_V(6); PG8_BAR;
    for (;;) {
        const bool has_next = S.next(ui + 1, nxt);
        const char* nA = has_next ? PG8_ABASE(nxt) : cA; const char* nB = has_next ? PG8_BBASE(nxt) : cB;
        for (int t = 0; t < nt; t += 2) {
            const bool last = (t == nt - 2);
            const char* a1 = cA + (size_t)(t + 1) * kstep;
            const char* a2 = last ? nA : cA + (size_t)(t + 2) * kstep; const char* b2 = last ? nB : cB + (size_t)(t + 2) * kstep;
            const char* a3 = a2 + kstep; const char* b3 = b2 + kstep;
            PG8_LDB(B0, 0, 0); PG8_LDB(B1, 0, 1); PG8_SCHED; PG8_LDA(At, 0, 0); PG8_STAGE(PG8_SA(1, 1), a1 + hA, voffA);
            PG8_WAIT_V(8); PG8_WAIT_L(0); PG8_BAR; PG8_MMA(0, 0, At, B0); PG8_MMA(0, 1, At, B1); PG8_BAR; PG8_SCHED;
            PG8_LDA(At, 0, 1); PG8_STAGE(PG8_SB(0, 0), b2, voffB); PG8_STAGE(PG8_SB(0, 1), b2 + hB, voffB); PG8_STAGE(PG8_SA(0, 0), a2, voffA);
            PG8_WAIT_V(8); PG8_WAIT_L(0); PG8_BAR; PG8_MMA(1, 0, At, B0); PG8_MMA(1, 1, At, B1); PG8_BAR; PG8_SCHED;
            PG8_LDB(B0, 1, 0); PG8_LDB(B1, 1, 1); PG8_SCHED; PG8_LDA(At, 1, 0); PG8_STAGE(PG8_SA(0, 1), a2 + hA, voffA);
            PG8_WAIT_V(8); PG8_WAIT_L(0); PG8_BAR; PG8_MMA(0, 0, At, B0); PG8_MMA(0, 1, At, B1); PG8_BAR; PG8_SCHED;
            PG8_LDA(At, 1, 1); PG8_STAGE(PG8_SB(1, 0), b3, voffB); PG8_STAGE(PG8_SB(1, 1), b3 + hB, voffB); PG8_STAGE(PG8_SA(1, 0), a3, voffA);
            PG8_WAIT_V(8); PG8_WAIT_L(0); PG8_BAR; PG8_MMA(1, 0, At, B0); PG8_MMA(1, 1, At, B1); PG8_BAR; PG8_SCHED;
        }
        if constexpr (ALIGN_EPI) { if (wr == 0) PG8_BAR; }
        E(acc, cur, wr, wc, fr, fq);
        if (!has_next) break;
#pragma unroll
        for (int a = 0; a < 2; ++a)
#pragma unroll
            for (int b = 0; b < 2; ++b)
#pragma unroll
                for (int m = 0; m < 4; ++m)
#pragma unroll
                    for (int n = 0; n < 2; ++n) acc[a][b][m][n] = (f32x4){0.f, 0.f, 0.f, 0.f};
        cur = nxt; cA = nA; cB = nB; ++ui;
        if constexpr (ALIGN_EPI) { if (wr == 1) PG8_BAR; }
    }
    PG8_WAIT_V(0);
    if constexpr (!ALIGN_EPI) { if (wr == 0) PG8_BAR; }
    PG8_BAR;
#undef PG8_SA
#undef PG8_SB
#undef PG8_STAGE
#undef PG8_LDA
#undef PG8_LDB
#undef PG8_MMA
#undef PG8_WAIT_V
#undef PG8_WAIT_L
#undef PG8_BAR
#undef PG8_SCHED
#undef PG8_ABASE
#undef PG8_BBASE
}
}

namespace attn {
constexpr int KSLOT = 12288, VSLOT = 8192;
constexpr int LDS_K = 0, LDS_V = 3 * KSLOT, LDS_WS = LDS_V + 3 * VSLOT, LDS_OST = LDS_WS + 8 * 256, LDS_TB = LDS_OST + 8 * 4096, LDS_BYTES = LDS_TB + 4 * TB_N * 4;
typedef LAS const char* lds_cptr;
typedef short v4i16_t __attribute__((ext_vector_type(4)));
#define SBAR() __builtin_amdgcn_sched_barrier(0)
#define PIN(x) asm volatile("" : "+v"(x))
#define MFMA32(a, b, c) __builtin_amdgcn_mfma_f32_32x32x16_bf16(a, b, c, 0, 0, 0)
#define WAIT_BAR(N) asm volatile("s_waitcnt vmcnt(" #N ") lgkmcnt(0)\n\ts_barrier" ::: "memory")
#define BAR_L() asm volatile("s_waitcnt lgkmcnt(0)\n\ts_barrier" ::: "memory")
__device__ __forceinline__ int crow(int r, int hi) { return (r & 3) + 8 * (r >> 2) + 4 * hi; }
__device__ __forceinline__ void glds16(const void* gsrc, unsigned lds_dst) { unsigned keep;
    asm volatile("s_mov_b32 %0, m0\n\ts_mov_b32 m0, %2\n\ts_nop 0\n\tglobal_load_lds_dwordx4 %1, off\n\ts_mov_b32 m0, %0" : "=&s"(keep) : "v"(gsrc), "s"(lds_dst) : "memory"); }
__device__ __forceinline__ s16x4 vtr(lds_cptr p) { return __builtin_bit_cast(s16x4, __builtin_amdgcn_ds_read_tr16_b64_v4i16((LAS v4i16_t*)p)); }
#define MX3(a, b, c) __builtin_fmaxf(__builtin_fmaxf((a), (b)), (c))
__device__ __forceinline__ float rowmax(const f32x16& p0, const f32x16& p1) {
    float a = MX3(p0[0], p0[1], p1[0]), b = MX3(p0[2], p0[3], p1[1]); a = MX3(a, p1[2], p1[3]);
#pragma unroll
    for (int r = 4; r < 16; r += 4) { a = MX3(a, p0[r], p0[r + 1]); b = MX3(b, p0[r + 2], p0[r + 3]); a = MX3(a, p1[r], p1[r + 1]); b = MX3(b, p1[r + 2], p1[r + 3]); }
    float m = __builtin_fmaxf(a, b); auto rr = __builtin_amdgcn_permlane32_swap(__float_as_uint(m), __float_as_uint(m), false, false);
    return __builtin_fmaxf(__uint_as_float(rr[0]), __uint_as_float(rr[1]));
}

struct Tensors {
    const bf16_t* Q; int pitchQ;
    const bf16_t* K;
    const bf16_t* V;
    const bf16_t* G; int pitchG;
    bf16_t* O; int pitchO;
};

struct UnitDesc {
    long qrow;
    int qpos;
    int qcol, ocol;
    int kvs;
    int t_lo, nt;
    int tb_off;
    float sink2;
};
template <int DQK>
__device__ __forceinline__ void attn_prefetch(const Tensors& T, int kvs, int t_lo, unsigned lds0, int wid, int lane) {
    constexpr long kts = (long)(DQK / 8) * 512, vts = 4096;
    const bf16_t* Kh = T.K + ((long)kvs * (SEQ / 64) + t_lo) * kts;
    const bf16_t* Vh = T.V + ((long)kvs * (SEQ / 64) + t_lo) * vts;
#pragma unroll
    for (int j = 0; j < 2; ++j) {
        glds16(Kh + j * kts + wid * 512 + lane * 8, (unsigned)__builtin_amdgcn_readfirstlane(lds0 + LDS_K + j * KSLOT + wid * 1024));
        if (DQK == 96) glds16(Kh + j * kts + (8 + (wid >> 1)) * 512 + lane * 8, (unsigned)__builtin_amdgcn_readfirstlane(lds0 + LDS_K + j * KSLOT + (8 + (wid >> 1)) * 1024));
        glds16(Vh + j * vts + wid * 512 + lane * 8, (unsigned)__builtin_amdgcn_readfirstlane(lds0 + LDS_V + j * VSLOT + wid * 1024));
    }
}
template <int DQK, bool SWA, int THR>
__device__ __forceinline__ void attn_unit(const Tensors& T, const UnitDesc& U, bool prefetched, bool has_next, int next_kvs, int next_t_lo, LAS unsigned char* shm, unsigned lds0,
                                          const float* tb_g  ) {
    constexpr int ND = DQK / 16;
    const int tid = fresh_tid(), lane = tid & 63, r32 = lane & 31, hi = lane >> 5; const int wid = __builtin_amdgcn_readfirstlane(tid >> 6);
    const bool grpB = wid >= 4;
    const int t_lo = U.t_lo, NT = U.nt;
    const float sink2 = U.sink2;
    const bf16_t* Qw = T.Q + U.qrow * T.pitchQ + U.qcol;
    constexpr long kts = (long)(DQK / 8) * 512, vts = 4096;
    const bf16_t* Kh = T.K + ((long)U.kvs * (SEQ / 64) + t_lo) * kts;
    const bf16_t* Vh = T.V + ((long)U.kvs * (SEQ / 64) + t_lo) * vts;
    LAS float* wsf = (LAS float*)(shm + LDS_WS) + wid * 64;
    const bf16_t* ksrc = Kh + wid * 512 + lane * 8;
    const bf16_t* krsrc = Kh + (8 + (wid >> 1)) * 512 + lane * 8;
    const bf16_t* vsrc = Vh + wid * 512 + lane * 8;
    const unsigned kdst = lds0 + LDS_K + wid * 1024, krdst = lds0 + LDS_K + (8 + (wid >> 1)) * 1024, vdst = lds0 + LDS_V + wid * 1024;
#define DMA_K(j, slot) do { glds16(ksrc + (long)(j) * kts, (unsigned)__builtin_amdgcn_readfirstlane(kdst + (slot) * KSLOT)); \
                           if (DQK == 96) glds16(krsrc + (long)(j) * kts, (unsigned)__builtin_amdgcn_readfirstlane(krdst + (slot) * KSLOT)); } while (0)
#define DMA_V(j, slot) glds16(vsrc + (long)(j) * vts, (unsigned)__builtin_amdgcn_readfirstlane(vdst + (slot) * VSLOT))
    const lds_cptr shm3 = (lds_cptr)shm;
    const lds_cptr kp0 = shm3 + LDS_K + hi * 1024 + r32 * 16;
    const lds_cptr vp0 = shm3 + LDS_V + ((lane >> 4) & 1) * 32 + (lane & 3) * 8 + (4 * hi + ((lane & 15) >> 2)) * 64;
    if (!prefetched) attn_prefetch<DQK>(T, U.kvs, t_lo, lds0, wid, lane);
    if (SWA) {
        LAS float* tbl = (LAS float*)(shm + LDS_TB);
        for (int i = tid; i < 4 * TB_N; i += 512) tbl[i] = tb_g[i];
    }
    bf16x8 qr[ND];
#pragma unroll
    for (int d0 = 0; d0 < ND; ++d0) qr[d0] = *reinterpret_cast<const bf16x8*>(&Qw[(long)r32 * T.pitchQ + d0 * 16 + hi * 8]);
    float mhat = SWA ? sink2 : 0.f;
    float l_reg = (SWA && hi == 0) ? 1.0f : 0.f;
    f32x16 o[2]; o[0] = f32x16{}; o[1] = f32x16{};
    f32x16 negm;
#pragma unroll
    for (int r = 0; r < 16; ++r) negm[r] = -mhat;
    PIN(negm);
    f32x16 p0, p1; u32x4 pw0, pw1, pw2, pw3;
    pw0 = u32x4{0u, 0u, 0u, 0u}; pw1 = pw0; pw2 = pw0; pw3 = pw0;
    s16x4 vlo[8], vhi[8];
#pragma unroll
    for (int i = 0; i < 8; ++i) { vlo[i] = s16x4{0, 0, 0, 0}; vhi[i] = s16x4{0, 0, 0, 0}; }
    const int tb_idx0 = U.tb_off + 64 * t_lo + 4 * hi - (U.qpos + r32) + 383;
    WAIT_BAR(0);
    SBAR();
    if (grpB) { WAIT_BAR(0); SBAR(); }
    int sl_prev = 2, sl_cur = 0, sl_next = 1;
    for (int j = 0; j < NT; ++j) {
        {
            bf16x8 kf[2 * ND];
            const lds_cptr kp = kp0 + sl_cur * KSLOT;
#pragma unroll
            for (int d0 = 0; d0 < ND; ++d0) { kf[2 * d0] = *(const LAS bf16x8*)(kp + d0 * 2048); kf[2 * d0 + 1] = *(const LAS bf16x8*)(kp + d0 * 2048 + 512); }
            f32x16 c0, c1;
            if (SWA) {
                const LAS float* tbl = (const LAS float*)(shm + LDS_TB) + (tb_idx0 + 64 * j);
#pragma unroll
                for (int r = 0; r < 16; ++r) { c0[r] = tbl[8 * (r >> 2) + (r & 3)] - mhat; c1[r] = tbl[32 + 8 * (r >> 2) + (r & 3)] - mhat; }
            } else { c0 = negm; c1 = negm; }
            SBAR();
            if (j > 0) {
#pragma unroll
                for (int ks = 0; ks < 4; ++ks) {
                    const u32x4 pw = ks == 0 ? pw0 : ks == 1 ? pw1 : ks == 2 ? pw2 : pw3;
#pragma unroll
                    for (int d0 = 0; d0 < 2; ++d0) {
                        const int i = d0 * 4 + ks;
                        const bf16x8 vf = (bf16x8){vlo[i][0], vlo[i][1], vlo[i][2], vlo[i][3], vhi[i][0], vhi[i][1], vhi[i][2], vhi[i][3]};
                        o[d0] = MFMA32(__builtin_bit_cast(bf16x8, pw), vf, o[d0]);
                    }
                }
            }
#pragma unroll
            for (int d0 = 0; d0 < ND; ++d0) {
                if (d0 == 0) { p0 = MFMA32(kf[0], qr[0], c0); p1 = MFMA32(kf[1], qr[0], c1); }
                else { p0 = MFMA32(kf[2 * d0], qr[d0], p0); p1 = MFMA32(kf[2 * d0 + 1], qr[d0], p1); }
            }
        }
        SBAR();
        WAIT_BAR(0);
        SBAR();
        if (j + 2 < NT) { DMA_K(j + 2, sl_prev); DMA_V(j + 2, sl_prev); }
        {
            const lds_cptr vp = vp0 + sl_cur * VSLOT;
#pragma unroll
            for (int i = 0; i < 8; ++i) { vlo[i] = vtr(vp + (i >> 2) * 4096 + (i & 3) * 1024); vhi[i] = vtr(vp + (i >> 2) * 4096 + (i & 3) * 1024 + 512); }
        }
        {
            const float rm = rowmax(p0, p1);
            const bool first = (!SWA) && (j == 0);
            bool resc = false;
            if (first || __any(rm > (float)THR)) {
                const float dl = first ? rm : __builtin_fmaxf(rm, 0.f);
                mhat += dl;
#pragma unroll
                for (int r = 0; r < 16; ++r) { p0[r] -= dl; p1[r] -= dl; }
#pragma unroll
                for (int r = 0; r < 16; ++r) negm[r] = -mhat;
                PIN(negm);
                if (!first) { const float f = __builtin_amdgcn_exp2f(-dl); l_reg *= f; if (hi == 0) wsf[r32] = f; resc = true; }
            }
            float sacc = 0.f;
#pragma unroll
            for (int r = 0; r < 16; ++r) { p0[r] = __builtin_amdgcn_exp2f(p0[r]); p1[r] = __builtin_amdgcn_exp2f(p1[r]); }
#pragma unroll
            for (int r = 0; r < 16; ++r) sacc += p0[r] + p1[r];
            l_reg += sacc;
            pw0 = (u32x4){cvt_pk_bf16(p0[0], p0[1]), cvt_pk_bf16(p0[2], p0[3]), cvt_pk_bf16(p0[4], p0[5]), cvt_pk_bf16(p0[6], p0[7])};
            pw1 = (u32x4){cvt_pk_bf16(p0[8], p0[9]), cvt_pk_bf16(p0[10], p0[11]), cvt_pk_bf16(p0[12], p0[13]), cvt_pk_bf16(p0[14], p0[15])};
            pw2 = (u32x4){cvt_pk_bf16(p1[0], p1[1]), cvt_pk_bf16(p1[2], p1[3]), cvt_pk_bf16(p1[4], p1[5]), cvt_pk_bf16(p1[6], p1[7])};
            pw3 = (u32x4){cvt_pk_bf16(p1[8], p1[9]), cvt_pk_bf16(p1[10], p1[11]), cvt_pk_bf16(p1[12], p1[13]), cvt_pk_bf16(p1[14], p1[15])};
            if (resc) {
#pragma unroll
                for (int r = 0; r < 16; ++r) { const float f = wsf[crow(r, hi)]; o[0][r] *= f; o[1][r] *= f; }
            }
            PIN(pw0); PIN(pw1); PIN(pw2); PIN(pw3); PIN(l_reg); PIN(o[0]); PIN(o[1]);
        }
        SBAR();
        BAR_L();
        SBAR();
        { const int tmp = sl_prev; sl_prev = sl_cur; sl_cur = sl_next; sl_next = tmp; }
    }
    if (grpB && has_next) attn_prefetch<DQK>(T, next_kvs, next_t_lo, lds0, wid, lane);
    {
#pragma unroll
        for (int ks = 0; ks < 4; ++ks) {
            const u32x4 pw = ks == 0 ? pw0 : ks == 1 ? pw1 : ks == 2 ? pw2 : pw3;
#pragma unroll
            for (int d0 = 0; d0 < 2; ++d0) {
                const int i = d0 * 4 + ks;
                const bf16x8 vf = (bf16x8){vlo[i][0], vlo[i][1], vlo[i][2], vlo[i][3], vhi[i][0], vhi[i][1], vhi[i][2], vhi[i][3]};
                o[d0] = MFMA32(__builtin_bit_cast(bf16x8, pw), vf, o[d0]);
            }
        }
    }
    SBAR();
    if (!grpB) { BAR_L(); SBAR(); }
    if (!grpB && has_next) attn_prefetch<DQK>(T, next_kvs, next_t_lo, lds0, wid, lane);
    { auto rr = __builtin_amdgcn_permlane32_swap(__float_as_uint(l_reg), __float_as_uint(l_reg), false, false); l_reg = __uint_as_float(rr[0]) + __uint_as_float(rr[1]); }
    if (hi == 0) wsf[32 + r32] = l_reg;
    float rli[16];
#pragma unroll
    for (int r = 0; r < 16; ++r) rli[r] = __builtin_amdgcn_rcpf(wsf[32 + crow(r, hi)]);
    {
        LAS bf16_t* stg = (LAS bf16_t*)(shm + LDS_OST) + wid * 2048;
#pragma unroll
        for (int r = 0; r < 16; ++r) { const int orow = crow(r, hi);
#pragma unroll
            for (int d0 = 0; d0 < 2; ++d0) { const unsigned w = cvt_pk_bf16(o[d0][r] * rli[r], 0.f); stg[orow * 64 + d0 * 32 + r32] = (bf16_t)(w & 0xffffu); } }
        const long orow0 = U.qrow; const int ocol = U.ocol;
#pragma unroll
        for (int i = 0; i < 4; ++i) {
            const int row = i * 8 + (lane >> 3), ch = lane & 7;
            const u32x4 ov = *(const LAS u32x4*)(stg + row * 64 + ch * 8);
            const u32x4 gv = *(const u32x4*)(T.G + (orow0 + row) * T.pitchG + ocol + ch * 8);
            u32x4 res;
            res.x = cvt_pk_bf16(bf_lo(ov.x) * bf_lo(gv.x), bf_hi(ov.x) * bf_hi(gv.x));
            res.y = cvt_pk_bf16(bf_lo(ov.y) * bf_lo(gv.y), bf_hi(ov.y) * bf_hi(gv.y));
            res.z = cvt_pk_bf16(bf_lo(ov.z) * bf_lo(gv.z), bf_hi(ov.z) * bf_hi(gv.z));
            res.w = cvt_pk_bf16(bf_lo(ov.w) * bf_lo(gv.w), bf_hi(ov.w) * bf_hi(gv.w));
            *(u32x4*)(T.O + (orow0 + row) * T.pitchO + ocol + ch * 8) = res;
        }
    }
    SBAR();
    BAR_L();
    SBAR();
#undef DMA_K
#undef DMA_V
}
#undef SBAR
#undef PIN
#undef MFMA32
#undef WAIT_BAR
#undef BAR_L
#undef MX3
}

#define XB_TMO      128
#define XB_XCNT(j)  (256  + 64 * (j))
#define XB_XSUB(j)  (1280 + 64 * (j))
#define XB_XGEN(j)  (2304 + 64 * (j))
#define XB_TOP      3328
#define XB_TOPGEN   3392
#define XCD_BAR_WORDS 3456
#define XB_SPIN_CAP (1u << 18)

__device__ __forceinline__ unsigned xb_ld(unsigned* p)              { return __hip_atomic_load(p, __ATOMIC_RELAXED, __HIP_MEMORY_SCOPE_AGENT); }
__device__ __forceinline__ unsigned xb_add(unsigned* p, unsigned v) { return __hip_atomic_fetch_add(p, v, __ATOMIC_RELAXED, __HIP_MEMORY_SCOPE_AGENT); }
__device__ __forceinline__ unsigned xb_xcc_id() { return (unsigned)__builtin_amdgcn_s_getreg((3 << 11) | 20) & 0xFu; }
#define XB_SPIN(cond, bar) do { unsigned _sp = 0; while (cond) { __builtin_amdgcn_s_sleep(1); \
    if ((++_sp & 255u) == 0u) { if (xb_ld(&(bar)[XB_TMO])) break; if (_sp > XB_SPIN_CAP) { atomicAdd(&(bar)[XB_TMO], 1u); break; } } } } while (0)

struct XcdBarrier {
    unsigned* bar; unsigned x;
    volatile LAS unsigned* st;
};

__device__ __forceinline__ XcdBarrier xcd_barrier_post(unsigned* bar, volatile LAS unsigned* st) {
    XcdBarrier b; b.bar = bar; b.x = xb_xcc_id(); b.st = st;
    if (threadIdx.x == 0) (void)xb_add(&bar[XB_XCNT(b.x)], 1u);
    return b;
}
__device__ __forceinline__ void xcd_barrier_complete(unsigned* bar, unsigned x, unsigned& nloc, unsigned& nx) {
    const unsigned G = gridDim.x * gridDim.y * gridDim.z;
    unsigned sum, cnt, mine, sp = 0u;
    for (;;) {
        sum = 0u; cnt = 0u; mine = 0u;
#pragma unroll
        for (unsigned j = 0; j < 16; ++j) { const unsigned c = xb_ld(&bar[XB_XCNT(j)]); sum += c; cnt += (c > 0u) ? 1u : 0u; mine = (j == x) ? c : mine; }
        if (sum == G) break;
        __builtin_amdgcn_s_sleep(1);
        if ((++sp & 255u) == 0u) { if (xb_ld(&bar[XB_TMO])) break; if (sp > XB_SPIN_CAP) { atomicAdd(&bar[XB_TMO], 1u); break; } }
    }
    nloc = mine > 0u ? mine : 1u; nx = cnt > 0u ? cnt : 1u;
}

__device__ __forceinline__ void xcd_barrier(const XcdBarrier& b) {
    asm volatile("s_waitcnt vmcnt(0)" ::: "memory");
    __syncthreads();
    if (threadIdx.x == 0) {
        unsigned* bar = b.bar;
        __builtin_amdgcn_s_waitcnt(0);
        unsigned nloc = b.st[0], nx = b.st[1];
        if (nloc == 0u) { xcd_barrier_complete(bar, b.x, nloc, nx); b.st[0] = nloc; b.st[1] = nx; }
        const unsigned old = xb_add(&bar[XB_XSUB(b.x)], 1u);
        const unsigned gen = old / nloc;
        if (old + 1u == (gen + 1u) * nloc) {
            __builtin_amdgcn_fence(__ATOMIC_RELEASE, "agent");
            asm volatile("s_waitcnt vmcnt(0)" ::: "memory");
            const unsigned og = xb_add(&bar[XB_TOP], 1u);
            const unsigned tg = og / nx;
            if (og + 1u == (tg + 1u) * nx) xb_add(&bar[XB_TOPGEN], 1u);
            else XB_SPIN(xb_ld(&bar[XB_TOPGEN]) == tg, bar);
            __builtin_amdgcn_fence(__ATOMIC_ACQUIRE, "agent");
            xb_add(&bar[XB_XGEN(b.x)], 1u);
            asm volatile("s_waitcnt vmcnt(0)" ::: "memory");
        } else {
            XB_SPIN(xb_ld(&bar[XB_XGEN(b.x)]) == gen, bar);
            __builtin_amdgcn_fence(__ATOMIC_ACQUIRE, "agent");
            asm volatile("s_waitcnt vmcnt(0)" ::: "memory");
        }
    }
    __syncthreads();
}

constexpr int NWAVES = 8;
constexpr size_t MiB = 1u << 20;
constexpr size_t WS_CTL = 0, CTL_ZERO_BYTES = 1 * MiB;
constexpr size_t WS_WIN = 2 * MiB;
constexpr size_t WS_WUP = 7 * MiB;
constexpr size_t WS_WOUT = 8 * MiB;
constexpr size_t WS_CS = 10 * MiB;
constexpr size_t WS_TB = 11 * MiB;
constexpr size_t WS_SSQ = 12 * MiB;
constexpr size_t WS_XB = 16 * MiB;
constexpr size_t WS_PROJ = 80 * MiB;
constexpr size_t WS_QM = 224 * MiB;
constexpr size_t WS_KM = 272 * MiB;
constexpr size_t WS_VM = 320 * MiB;
constexpr size_t WS_MIX = 352 * MiB;
constexpr size_t WS_KSB = 416 * MiB;
constexpr size_t WS_VSB = 424 * MiB;
constexpr size_t WS_END = 432 * MiB;
constexpr int CW_BAR = 4096;
static_assert((CW_BAR + XCD_BAR_WORDS) * 4 <= (int)CTL_ZERO_BYTES, "CTL words inside the memset region");
constexpr int RING_OFF = 0, RING_BYTES = 131072;
constexpr int LDSCTL_OFF = RING_BYTES, MISC_OFF = LDSCTL_OFF + 320;
constexpr int LDS_BYTES = 147456;
static_assert(attn::LDS_BYTES <= RING_BYTES && pg8::STAGE_BYTES <= RING_BYTES, "phase scratch fits the ring region");

struct Args { const float* x; const float* w_in; const float* g_q; const float* g_kv; const float* w_uq; const float* w_ukv; const float* sink; const float* rel_bias;
              const float* w_out; const float* ln_g; const float* ln_b; float* out; unsigned char* ws; };

__device__ __forceinline__ float wave_sum(float v) {
#pragma unroll
    for (int o = 1; o < 64; o <<= 1) v += __shfl_xor(v, o);
    return v;
}
__device__ __forceinline__ int map_col(int kind, int n) {
    if (kind == 0) {
        if (n < 384) return n;
        if (n < 416) { const int e = n - 384; return SC_KR + (e >> 1) + 16 * (e & 1); }
        if (n < 512) return -1;
        if (n < 1024) return SC_GA + (n - 512);
        if (n < 1536) return SC_QS + (n - 1024);
        if (n < 1664) return SC_KS + (n - 1536);
        if (n < 1792) return SC_VS + (n - 1664);
        return SC_GB + (n - 1792);
    } else if (kind == 1) {
        const int h = n / 96, d = n % 96; if (d < 64) return n; const int e = d - 64; return h * 96 + 64 + (e >> 1) + 16 * (e & 1);
    } else if (kind == 2) {
        if (n < 512) return (n >> 6) * 128 + (n & 63);
        const int c = n - 512; return (c >> 6) * 128 + 64 + (c & 63);
    }
    return n;
}
__device__ __forceinline__ void tr_item(const float* W, int Nsrc, int Kvalid, bf16_t* WT, int ldt, int drow, int k0, int nloc0, int kind, const float* kscale, LAS float* scr, int lane) {
    const int sc = map_col(kind, nloc0 + (lane & 31));
#pragma unroll 8
    for (int i = 0; i < 32; ++i) { const int kk = 2 * i + (lane >> 5), k = k0 + kk; float v = 0.f;
        if (sc >= 0 && k < Kvalid) { v = W[(size_t)k * Nsrc + sc]; if (kscale) v *= kscale[k]; }
        scr[kk * 33 + (lane & 31)] = v; }
    asm volatile("s_waitcnt lgkmcnt(0)" ::: "memory");
    const int c = lane & 7;
#pragma unroll
    for (int j = 0; j < 4; ++j) { const int n = (lane >> 3) + 8 * j; const LAS float* s = scr + (8 * c) * 33 + n;
        u32x4 o; o.x = cvt_pk_bf16(s[0 * 33], s[1 * 33]); o.y = cvt_pk_bf16(s[2 * 33], s[3 * 33]); o.z = cvt_pk_bf16(s[4 * 33], s[5 * 33]); o.w = cvt_pk_bf16(s[6 * 33], s[7 * 33]);
        *(u32x4*)(WT + (size_t)(drow + nloc0 + n) * ldt + k0 + 8 * c) = o; }
    asm volatile("s_waitcnt lgkmcnt(0)" ::: "memory");
}
__device__ __forceinline__ int t5_bucket(int rel) {
    const int n = rel < 0 ? -rel : rel;
    int s = n;
    if (n >= 8) { s = 8 + (n >= 12) + (n >= 16) + (n >= 23) + (n >= 32) + (n >= 46) + (n >= 64) + (n >= 91); if (s > 15) s = 15; }
    return (rel > 0 ? 16 : 0) + s;
}

__global__ void __launch_bounds__(NWAVES * 64, 2) __attribute__((amdgpu_waves_per_eu(2, 2))) fwd_kernel(Args args) {
    extern __shared__ __attribute__((aligned(16))) unsigned char lds[];
    LAS unsigned char* L = (LAS unsigned char*)lds;
    volatile LAS unsigned* MISC = (volatile LAS unsigned*)(L + MISC_OFF);
    const int G = gridDim.x, bx = blockIdx.x;
    const int vcu = (G % 8 == 0) ? (bx % 8) * (G / 8) + bx / 8 : bx;
    unsigned* ctl = (unsigned*)(args.ws + WS_CTL);
#define WS_PTRS() unsigned char* ws = args.ws; asm volatile("" : "+s"(ws));
    for (int u = threadIdx.x; u < (LDS_BYTES - LDSCTL_OFF) / 4; u += NWAVES * 64) ((LAS unsigned*)(L + LDSCTL_OFF))[u] = 0u;
    __syncthreads();
    XcdBarrier bar = xcd_barrier_post(ctl + CW_BAR, MISC + 8);

    {
        const int tid = fresh_tid(), lane = tid & 63, wave = __builtin_amdgcn_readfirstlane(tid >> 6);
        WS_PTRS(); bf16_t* Win_t = (bf16_t*)(ws + WS_WIN); bf16_t* Wup_t = (bf16_t*)(ws + WS_WUP); bf16_t* Wout_t = (bf16_t*)(ws + WS_WOUT);
        float* CS = (float*)(ws + WS_CS); float* TB = (float*)(ws + WS_TB); bf16_t* XB = (bf16_t*)(ws + WS_XB);
        LAS float* scr = (LAS float*)(L + RING_OFF + wave * 16384);
        const int gw = vcu * NWAVES + wave, NGW = G * NWAVES;
        constexpr int I_IN = 16 * 72, I_UQ = 4 * 24, I_UKV = 4 * 32, I_OUT = 16 * 32, NITEMS = I_IN + I_UQ + I_UKV + I_OUT;
        for (int it = gw; it < NITEMS; it += NGW) {
            int r = it;
            if (r < I_IN) { tr_item(args.w_in, D_IN, 1024, Win_t, 1024, 0, 64 * (r / 72), 32 * (r % 72), 0, nullptr, scr, lane); continue; } r -= I_IN;
            if (r < I_UQ) { tr_item(args.w_uq, 768, 256, Wup_t, 256, 0, 64 * (r / 24), 32 * (r % 24), 1, args.g_q, scr, lane); continue; } r -= I_UQ;
            if (r < I_UKV) { tr_item(args.w_ukv, 1024, 128, Wup_t, 256, 768, 64 * (r / 32), 32 * (r % 32), 2, args.g_kv, scr, lane); continue; } r -= I_UKV;
            tr_item(args.w_out, 1024, 1024, Wout_t, 1024, 0, 64 * (r / 32), 32 * (r % 32), 3, nullptr, scr, lane);
        }
        for (int m = gw; m < MTOK; m += NGW) {
            const GAS f32x4* xr = (const GAS f32x4*)(args.x + (size_t)m * DMODEL) + lane;
            GAS u32x2* o8 = (GAS u32x2*)(XB + (size_t)m * DMODEL) + lane;
            f32x4 v[4];
#pragma unroll
            for (int j = 0; j < 4; ++j) v[j] = xr[64 * j];
#pragma unroll
            for (int j = 0; j < 4; ++j) { u32x2 w; w.x = cvt_pk_bf16(v[j][0], v[j][1]); w.y = cvt_pk_bf16(v[j][2], v[j][3]); o8[64 * j] = w; }
        }
        for (int e = vcu * (NWAVES * 64) + tid; e < SEQ * 16; e += G * NWAVES * 64) {
            const int pos = e >> 4, i = e & 15;
            const float inv = (float)pow(10000.0, -(double)(2 * i) / 32.0);
            const float ang = (float)pos * inv;
            CS[pos * 32 + i] = (float)cos((double)ang); CS[pos * 32 + 16 + i] = (float)sin((double)ang);
        }
        for (int e = vcu * (NWAVES * 64) + tid; e < 8 * TB_N; e += G * NWAVES * 64) {
            const int h = e / TB_N, idx = e % TB_N, rel = idx - 383;
            float v = NEG_BIG;
            if (rel >= -128 && rel <= 128) v = args.rel_bias[t5_bucket(rel) * 8 + h] * LOG2E;
            TB[e] = v;
        }
    }
    xcd_barrier(bar);

    {
        WS_PTRS();
        pg8::Gemm g{(const bf16_t*)(ws + WS_XB), (const bf16_t*)(ws + WS_WIN)};
        pg8::StaticOrder S; S.init(MTOK / 256, NPROJ / 256, G, bx);
        pg8::EpiProj E{(bf16_t*)(ws + WS_PROJ), (bf16_t*)(ws + WS_KM), (bf16_t*)(ws + WS_KSB), (bf16_t*)(ws + WS_VSB), (float*)(ws + WS_SSQ), (const float*)(ws + WS_CS)};
        pg8::gemm_phase<pg8::GemmCfg<1024, 1024, 1024, 1 << 20, 0>, pg8::EpiProj, true>(L + RING_OFF, g, S, E);
    }
    xcd_barrier(bar);

    {
        WS_PTRS();
        pg8::Gemm g{(const bf16_t*)(ws + WS_PROJ), (const bf16_t*)(ws + WS_WUP)};
        pg8::StaticOrder S; S.init(MTOK / 256, NUP / 256, G, bx);
        pg8::EpiUp E{(bf16_t*)(ws + WS_QM), (bf16_t*)(ws + WS_KM), (bf16_t*)(ws + WS_VM), (const float*)(ws + WS_SSQ), (const float*)(ws + WS_CS)};
        pg8::gemm_phase<pg8::GemmCfg<NPROJ, 256, 256, 3, 256>, pg8::EpiUp, true>(L + RING_OFF, g, S, E);
    }
    xcd_barrier(bar);

    {
        WS_PTRS(); bf16_t* PROJ = (bf16_t*)(ws + WS_PROJ); bf16_t* Qm = (bf16_t*)(ws + WS_QM); bf16_t* Km = (bf16_t*)(ws + WS_KM); bf16_t* Vm = (bf16_t*)(ws + WS_VM);
        bf16_t* MIX = (bf16_t*)(ws + WS_MIX); const float* TB = (const float*)(ws + WS_TB);
        const unsigned lds0 = (unsigned)(uintptr_t)lds + RING_OFF;
        const int wv = __builtin_amdgcn_readfirstlane((int)threadIdx.x >> 6);
        attn::Tensors TA{Qm, QM_PITCH, Km, Vm, PROJ + PC_GA, NPROJ, MIX, MIX_PITCH};
        {
            bool pre = false;
            for (int uid = vcu; uid < 1024; uid += G) {
                const int bh = uid >> 5, qb = uid & 31, b = bh >> 3, h = bh & 7;
                attn::UnitDesc U; U.qpos = qb * 256 + wv * 32; U.qrow = (long)b * SEQ + U.qpos; U.qcol = h * 96; U.ocol = h * 64; U.kvs = bh; U.t_lo = 0; U.nt = SEQ / 64; U.tb_off = 0; U.sink2 = 0.f;
                const bool nxt = uid + G < 1024;
                attn::attn_unit<96, false, 8>(TA, U, pre, nxt, (uid + G) >> 5, 0, L + RING_OFF, lds0, nullptr);
                pre = nxt;
            }
        }
        attn::Tensors TS{PROJ + PC_QS, NPROJ, (const bf16_t*)(ws + WS_KSB), (const bf16_t*)(ws + WS_VSB), PROJ + PC_GB, NPROJ, MIX + 512, MIX_PITCH};
        {
            bool pre = false;
            for (int uid = vcu; uid < 1024; uid += G) {
                const int bk = uid >> 7, u = uid & 127, b = bk >> 1, h = (bk & 1) * 4 + (wv >> 1);
                attn::UnitDesc U; U.qpos = u * 64 + (wv & 1) * 32; U.qrow = (long)b * SEQ + U.qpos; U.qcol = h * 64; U.ocol = h * 64; U.kvs = bk;
                U.t_lo = u - 2 < 0 ? 0 : u - 2; U.nt = (u + 3 > SEQ / 64 ? SEQ / 64 : u + 3) - U.t_lo; U.tb_off = (wv >> 1) * TB_N; U.sink2 = args.sink[h] * LOG2E;
                const bool nxt = uid + G < 1024; const int un = (uid + G) & 127;
                attn::attn_unit<64, true, 8>(TS, U, pre, nxt, (uid + G) >> 7, un - 2 < 0 ? 0 : un - 2, L + RING_OFF, lds0, TB + (bk & 1) * 4 * TB_N);
                pre = nxt;
            }
        }
    }
    xcd_barrier(bar);

    {
        WS_PTRS();
        pg8::Gemm g{(const bf16_t*)(ws + WS_MIX), (const bf16_t*)(ws + WS_WOUT)};
        pg8::StaticOrder S; S.init(MTOK / 256, DMODEL / 256, G, bx);
        pg8::EpiOut E{args.x, args.out};
        pg8::gemm_phase<pg8::GemmCfg<1024, 1024, 1024, 1 << 20, 0>, pg8::EpiOut, true>(L + RING_OFF, g, S, E);
    }
    xcd_barrier(bar);

    {
        const int tid = fresh_tid(), lane = tid & 63, wave = __builtin_amdgcn_readfirstlane(tid >> 6);
        const int gw = vcu * NWAVES + wave, NGW = G * NWAVES;
        f32x4 gv[4], bv[4];
#pragma unroll
        for (int j = 0; j < 4; ++j) { gv[j] = ((const f32x4*)args.ln_g)[64 * j + lane]; bv[j] = ((const f32x4*)args.ln_b)[64 * j + lane]; }
        for (int m = gw; m < MTOK; m += NGW) {
            GAS f32x4* xr = (GAS f32x4*)(args.out + (size_t)m * DMODEL) + lane;
            f32x4 v[4]; float s = 0.f;
#pragma unroll
            for (int j = 0; j < 4; ++j) { v[j] = xr[64 * j]; s += (v[j][0] + v[j][1]) + (v[j][2] + v[j][3]); }
            const float mean = wave_sum(s) * (1.f / DMODEL); float s2 = 0.f;
#pragma unroll
            for (int j = 0; j < 4; ++j) { v[j] = v[j] - mean; s2 += (v[j][0] * v[j][0] + v[j][1] * v[j][1]) + (v[j][2] * v[j][2] + v[j][3] * v[j][3]); }
            const float rstd = 1.f / sqrtf(wave_sum(s2) * (1.f / DMODEL) + LN_EPS);
#pragma unroll
            for (int j = 0; j < 4; ++j) xr[64 * j] = v[j] * rstd * gv[j] + bv[j];
        }
    }
}

extern "C" void kernel_launch(void* const* d_in, const int* in_sizes, int n_in, void* d_out, int out_size, void* d_ws, size_t ws_size, hipStream_t stream) {
    static int grid = 0;
    if (grid == 0) {
        if (n_in != 11 || in_sizes[0] != MTOK * DMODEL || out_size != MTOK * DMODEL || ws_size < WS_END) {
            fprintf(stderr, "kernel_launch: unexpected shapes (n_in %d, in0 %d, out %d, ws %zu); nothing launched\n", n_in, n_in > 0 ? in_sizes[0] : -1, out_size, ws_size); grid = -1; return; }
        int dev = 0, cus = 0;
        if (hipGetDevice(&dev) != hipSuccess || hipDeviceGetAttribute(&cus, hipDeviceAttributeMultiprocessorCount, dev) != hipSuccess) { fprintf(stderr, "kernel_launch: device query failed\n"); grid = -1; return; }
        if (hipFuncSetAttribute((const void*)fwd_kernel, hipFuncAttributeMaxDynamicSharedMemorySize, LDS_BYTES) != hipSuccess) { fprintf(stderr, "kernel_launch: hipFuncSetAttribute failed\n"); grid = -1; return; }
        (void)hipGetLastError();
        grid = cus;
    }
    if (grid < 0) return;
    if (hipMemsetAsync((char*)d_ws + WS_CTL, 0, CTL_ZERO_BYTES, stream) != hipSuccess) { fprintf(stderr, "kernel_launch: hipMemsetAsync failed\n"); return; }
    Args a{};
    a.x = (const float*)d_in[0]; a.w_in = (const float*)d_in[1]; a.g_q = (const float*)d_in[2]; a.g_kv = (const float*)d_in[3]; a.w_uq = (const float*)d_in[4]; a.w_ukv = (const float*)d_in[5];
    a.sink = (const float*)d_in[6]; a.rel_bias = (const float*)d_in[7]; a.w_out = (const float*)d_in[8]; a.ln_g = (const float*)d_in[9]; a.ln_b = (const float*)d_in[10];
    a.out = (float*)d_out; a.ws = (unsigned char*)d_ws;
    hipLaunchKernelGGL(fwd_kernel, dim3(grid), dim3(NWAVES * 64), LDS_BYTES, stream, a);
    const hipError_t le = hipPeekAtLastError();
    if (le != hipSuccess) fprintf(stderr, "kernel_launch: launch failed: %s\n", hipGetErrorName(le));
}
```
